# Optimizing an MI355X kernel written in HIP

```python
import jax, jax.numpy as jnp
from jax import lax
import numpy as np

D_MODEL = 2048
BATCH = 4
SEQ = 2048
DEPTH = 2

CTX_LEN = 256
GRID_W = 64
MLA_HEADS = 6
MLA_Q_RANK = 512
MLA_KV_RANK = 512
MLA_NOPE = 128
MLA_ROPE = 64
MLA_V = 128
MLA_QK = MLA_NOPE + MLA_ROPE
MLA_OUT = MLA_HEADS * MLA_V
CONV_DIM = 512
CONV_WIDTH = 3
NA_HEADS = 6
NA_HEAD_DIM = 128
NA_DIM = NA_HEADS * NA_HEAD_DIM
NA_WIN_R = 8
NA_WIN_C = 16
MIX_DIM = MLA_OUT + CONV_DIM + NA_DIM
OFF_MLA_Q = 0
OFF_MLA_KV = OFF_MLA_Q + MLA_Q_RANK
OFF_CONV_B = OFF_MLA_KV + MLA_KV_RANK + MLA_ROPE
OFF_CONV_C = OFF_CONV_B + CONV_DIM
OFF_CONV_H = OFF_CONV_C + CONV_DIM
OFF_NA_Q = OFF_CONV_H + CONV_DIM
OFF_NA_K = OFF_NA_Q + NA_DIM
OFF_NA_V = OFF_NA_K + NA_DIM
IN_DIM = OFF_NA_V + NA_DIM
D_FF = -(-8 * D_MODEL // (3 * 256)) * 256
ROPE_THETA = 10000.0
LN_EPS = 1e-6
RMS_EPS = 1e-6
Q_BLOCK = 128
ADA_SCALE = 0.5
DEEPNORM_ALPHA = (2 * DEPTH) ** 0.25
DEEPNORM_BETA = (8 * DEPTH) ** -0.25

kernel_name = 'hybrid_mla_conv_natten_prefix_block'


def layer_norm(x, g, b):
    xf = x.astype(jnp.float32)
    mu = jnp.mean(xf, axis=-1, keepdims=True)
    var = jnp.mean(jnp.square(xf - mu), axis=-1, keepdims=True)
    return ((xf - mu) * lax.rsqrt(var + LN_EPS) * g + b).astype(x.dtype)


def rms_norm(x, g):
    xf = x.astype(jnp.float32)
    return (xf * lax.rsqrt(jnp.mean(xf * xf, axis=-1, keepdims=True) + RMS_EPS) * g).astype(x.dtype)


def modulate(x, shift, scale):
    return x * (1 + scale) + shift


def heads(z, lo, n_heads, d):
    return z[..., lo:lo + n_heads * d].reshape(*z.shape[:-1], n_heads, d)


def axial_rope_tables(n_tokens, dtype):
    t = jnp.arange(n_tokens)
    row = (t // GRID_W).astype(jnp.float32)
    col = (t % GRID_W).astype(jnp.float32)
    n_freq = MLA_ROPE // 4
    inv = ROPE_THETA ** (-jnp.arange(n_freq, dtype=jnp.float32) / n_freq)
    ar = row[:, None] * inv
    ac = col[:, None] * inv
    ang = jnp.concatenate([ar, ar, ac, ac], axis=-1)
    return jnp.cos(ang).astype(dtype), jnp.sin(ang).astype(dtype)


def apply_axial_rope(x, cos, sin):
    a1, a2, b1, b2 = jnp.split(x, 4, axis=-1)
    rot = jnp.concatenate([-a2, a1, -b2, b1], axis=-1)
    return x * cos + rot * sin


def full_attention(q, k, v):
    scale = q.shape[-1] ** -0.5
    s = jnp.einsum('bqhd,bkhd->bhqk', q, k).astype(jnp.float32) * scale
    p = jax.nn.softmax(s, axis=-1).astype(v.dtype)
    return jnp.einsum('bhqk,bkhd->bqhd', p, v)


def blocked_attention(q, k, v):
    B, S, H, d = q.shape
    nb = S // Q_BLOCK
    qb = jnp.moveaxis(q.reshape(B, nb, Q_BLOCK, H, d), 1, 0)
    o = lax.map(lambda qi: full_attention(qi, k, v), qb)
    return jnp.moveaxis(o, 0, 1).reshape(B, S, H, v.shape[-1])


def mla_queries(z, g_q, w_qb):
    cq = rms_norm(z[..., OFF_MLA_Q:OFF_MLA_Q + MLA_Q_RANK], g_q)
    q = (cq @ w_qb).reshape(*z.shape[:-1], MLA_HEADS, MLA_QK)
    return q[..., :MLA_NOPE], q[..., MLA_NOPE:]


def mla_kv(z, g_kv, w_kvb):
    ckv = rms_norm(z[..., OFF_MLA_KV:OFF_MLA_KV + MLA_KV_RANK], g_kv)
    k_rope = z[..., OFF_MLA_KV + MLA_KV_RANK:OFF_CONV_B]
    kv = (ckv @ w_kvb).reshape(*z.shape[:-1], MLA_HEADS, MLA_NOPE + MLA_V)
    return kv[..., :MLA_NOPE], k_rope, kv[..., MLA_NOPE:]


def mla_keys(k_nope, k_rope):
    kr = jnp.broadcast_to(k_rope[..., None, :], k_nope.shape[:-1] + (MLA_ROPE,))
    return jnp.concatenate([k_nope, kr], axis=-1)


def gated_short_conv(z, w):
    gb = z[..., OFF_CONV_B:OFF_CONV_C]
    gc = z[..., OFF_CONV_C:OFF_CONV_H]
    h = z[..., OFF_CONV_H:OFF_NA_Q]
    u = jnp.pad(gc * h, ((0, 0), (1, 1), (0, 0)))
    y = u[:, :-2] * w[0] + u[:, 1:-1] * w[1] + u[:, 2:] * w[2]
    return gb * y


def neighbourhood_attention(q, k, v, k_ctx, v_ctx, rpb):
    B, S, H, d = q.shape
    rows = S // GRID_W
    kr = min(NA_WIN_R, rows)
    scale = d ** -0.5
    qg = q.reshape(B, rows, GRID_W, H, d)
    kg = k.reshape(B, rows, GRID_W, H, d)
    vg = v.reshape(B, rows, GRID_W, H, d)
    r = jnp.arange(rows)
    r0 = jnp.clip(r - kr // 2, 0, rows - kr)
    row_idx = r0[:, None] + jnp.arange(kr)[None, :]
    k_band = kg[:, row_idx]
    v_band = vg[:, row_idx]
    col = jnp.arange(GRID_W)
    c0 = jnp.clip(col - NA_WIN_C // 2, 0, GRID_W - NA_WIN_C)
    in_win = (col[None, :] >= c0[:, None]) & (col[None, :] < c0[:, None] + NA_WIN_C)
    dr = row_idx - r[:, None] + NA_WIN_R - 1
    dc = jnp.clip(col[None, :] - col[:, None], 1 - NA_WIN_C, NA_WIN_C - 1) + NA_WIN_C - 1
    bias = rpb[:, dr[:, None, :, None], dc[None, :, None, :]]
    s_loc = jnp.einsum('brqhd,brikhd->bhrqik', qg, k_band).astype(jnp.float32) * scale + bias.astype(jnp.float32)
    s_loc = jnp.where(in_win[:, None, :], s_loc, -jnp.inf)
    s_ctx = jnp.einsum('brqhd,bmhd->bhrqm', qg, k_ctx).astype(jnp.float32) * scale
    s = jnp.concatenate([s_loc.reshape(B, H, rows, GRID_W, kr * GRID_W), s_ctx], axis=-1)
    p = jax.nn.softmax(s, axis=-1).astype(v.dtype)
    p_loc = p[..., :kr * GRID_W].reshape(B, H, rows, GRID_W, kr, GRID_W)
    p_ctx = p[..., kr * GRID_W:]
    o = (jnp.einsum('bhrqik,brikhd->brqhd', p_loc, v_band)
         + jnp.einsum('bhrqm,bmhd->brqhd', p_ctx, v_ctx))
    return o.reshape(B, S, H, d)


def swiglu(x, w_gate, w_up, w_down):
    return (jax.nn.silu(x @ w_gate) * (x @ w_up)) @ w_down


def setup_inputs(seed: int = 0) -> dict:
    key = jax.random.key(seed)
    ks = jax.random.split(key, 24)
    L = DEPTH

    def nrm(k, shape, s):
        return jax.random.normal(k, shape, jnp.float32) * s

    return {
        'x': nrm(ks[0], (BATCH, SEQ, D_MODEL), 1.0),
        'c': nrm(ks[1], (BATCH, D_MODEL), 1.0),
        'ctx': nrm(ks[2], (BATCH, CTX_LEN, D_MODEL), 1.0),
        'c_ctx': nrm(ks[3], (D_MODEL,), 1.0),
        'ada_w': nrm(ks[4], (L, D_MODEL, 6 * D_MODEL), ADA_SCALE * D_MODEL ** -0.5),
        'ada_b': nrm(ks[5], (L, 6 * D_MODEL), 0.02),
        'w_in': nrm(ks[6], (L, D_MODEL, IN_DIM), D_MODEL ** -0.5),
        'mla_q_norm': 1.0 + nrm(ks[7], (L, MLA_Q_RANK), 0.02),
        'mla_wq_b': nrm(ks[8], (L, MLA_Q_RANK, MLA_HEADS * MLA_QK), MLA_Q_RANK ** -0.5),
        'mla_kv_norm': 1.0 + nrm(ks[9], (L, MLA_KV_RANK), 0.02),
        'mla_wkv_b': nrm(ks[10], (L, MLA_KV_RANK, MLA_HEADS * (MLA_NOPE + MLA_V)), MLA_KV_RANK ** -0.5),
        'conv_w': nrm(ks[11], (L, CONV_WIDTH, CONV_DIM), CONV_WIDTH ** -0.5),
        'na_rpb': nrm(ks[12], (L, NA_HEADS, 2 * NA_WIN_R - 1, 2 * NA_WIN_C - 1), 0.1),
        'w_out': nrm(ks[13], (L, MIX_DIM, D_MODEL), DEEPNORM_BETA * MIX_DIM ** -0.5),
        'ln1_g': 1.0 + nrm(ks[14], (L, D_MODEL), 0.02),
        'ln1_b': nrm(ks[15], (L, D_MODEL), 0.02),
        'ffn_w_gate': nrm(ks[16], (L, D_MODEL, D_FF), D_MODEL ** -0.5),
        'ffn_w_up': nrm(ks[17], (L, D_MODEL, D_FF), D_MODEL ** -0.5),
        'ffn_w_down': nrm(ks[18], (L, D_FF, D_MODEL), DEEPNORM_BETA * D_FF ** -0.5),
        'ln2_g': 1.0 + nrm(ks[19], (L, D_MODEL), 0.02),
        'ln2_b': nrm(ks[20], (L, D_MODEL), 0.02),
    }


def reference(x, c, ctx, c_ctx, ada_w, ada_b, w_in, mla_q_norm, mla_wq_b, mla_kv_norm, mla_wkv_b,
              conv_w, na_rpb, w_out, ln1_g, ln1_b, ffn_w_gate, ffn_w_up, ffn_w_down, ln2_g, ln2_b):
    B, S, _ = x.shape
    cos, sin = axial_rope_tables(S, x.dtype)
    h_ctx = ctx
    for l in range(DEPTH):
        last = l == DEPTH - 1
        sh1, sc1, g1, sh2, sc2, g2 = jnp.split(jax.nn.silu(c) @ ada_w[l] + ada_b[l], 6, axis=-1)
        csh1, csc1, cg1, csh2, csc2, cg2 = jnp.split(jax.nn.silu(c_ctx) @ ada_w[l] + ada_b[l], 6, axis=-1)

        z_lat = modulate(x, sh1[:, None], sc1[:, None]) @ w_in[l]
        z_ctx = modulate(h_ctx, csh1, csc1) @ w_in[l]

        qn, qr = mla_queries(z_lat, mla_q_norm[l], mla_wq_b[l])
        kn, kr, v = mla_kv(z_lat, mla_kv_norm[l], mla_wkv_b[l])
        q_lat = jnp.concatenate([qn, apply_axial_rope(qr, cos[:, None, :], sin[:, None, :])], axis=-1)
        k_lat = mla_keys(kn, apply_axial_rope(kr, cos, sin))
        ckn, ckr, cv = mla_kv(z_ctx, mla_kv_norm[l], mla_wkv_b[l])
        k_ctx = mla_keys(ckn, ckr)
        a_lat = blocked_attention(q_lat, jnp.concatenate([k_ctx, k_lat], axis=1),
                                  jnp.concatenate([cv, v], axis=1))

        conv_lat = gated_short_conv(z_lat, conv_w[l])

        nq = heads(z_lat, OFF_NA_Q, NA_HEADS, NA_HEAD_DIM)
        nk = heads(z_lat, OFF_NA_K, NA_HEADS, NA_HEAD_DIM)
        nv = heads(z_lat, OFF_NA_V, NA_HEADS, NA_HEAD_DIM)
        cnk = heads(z_ctx, OFF_NA_K, NA_HEADS, NA_HEAD_DIM)
        cnv = heads(z_ctx, OFF_NA_V, NA_HEADS, NA_HEAD_DIM)
        n_lat = neighbourhood_attention(nq, nk, nv, cnk, cnv, na_rpb[l])

        mix = jnp.concatenate([a_lat.reshape(B, S, MLA_OUT), conv_lat, n_lat.reshape(B, S, NA_DIM)], axis=-1)
        x_new = layer_norm(DEEPNORM_ALPHA * x + g1[:, None] * (mix @ w_out[l]), ln1_g[l], ln1_b[l])
        ffn = swiglu(modulate(x_new, sh2[:, None], sc2[:, None]), ffn_w_gate[l], ffn_w_up[l], ffn_w_down[l])
        x_new = layer_norm(DEEPNORM_ALPHA * x_new + g2[:, None] * ffn, ln2_g[l], ln2_b[l])

        if not last:
            cqn, cqr = mla_queries(z_ctx, mla_q_norm[l], mla_wq_b[l])
            a_ctx = full_attention(jnp.concatenate([cqn, cqr], axis=-1), k_ctx, cv)
            conv_ctx = gated_short_conv(z_ctx, conv_w[l])
            cnq = heads(z_ctx, OFF_NA_Q, NA_HEADS, NA_HEAD_DIM)
            n_ctx = full_attention(cnq, cnk, cnv)
            M = h_ctx.shape[1]
            mix_c = jnp.concatenate([a_ctx.reshape(B, M, MLA_OUT), conv_ctx, n_ctx.reshape(B, M, NA_DIM)], axis=-1)
            hc = layer_norm(DEEPNORM_ALPHA * h_ctx + cg1 * (mix_c @ w_out[l]), ln1_g[l], ln1_b[l])
            ffn_c = swiglu(modulate(hc, csh2, csc2), ffn_w_gate[l], ffn_w_up[l], ffn_w_down[l])
            h_ctx = layer_norm(DEEPNORM_ALPHA * hc + cg2 * ffn_c, ln2_g[l], ln2_b[l])
        x = x_new
    return x
```

```cpp
#include <hip/hip_runtime.h>
#include <hip/hip_cooperative_groups.h>
#include <cstdio>
#include <cstdint>
namespace cg = cooperative_groups;

#define LAS __attribute__((address_space(3)))
typedef unsigned short bf16_t;
typedef short bf16x8 __attribute__((ext_vector_type(8)));
typedef short s16x4 __attribute__((ext_vector_type(4)));
typedef float f32x4 __attribute__((ext_vector_type(4)));
typedef float f32x16 __attribute__((ext_vector_type(16)));
typedef unsigned u32x4 __attribute__((ext_vector_type(4)));
typedef unsigned u32x2 __attribute__((ext_vector_type(2)));

constexpr int DM = 2048, NBATCH = 4, SEQ = 2048, CTXL = 256, NLAT = NBATCH * SEQ, NCTX = NBATCH * CTXL, MTOT = NLAT + NCTX;
constexpr int INDIM = 4928, ZLD = 5120, QLD = 3072, FF = 5632, MODLD = 6 * DM;
constexpr int ZC_Q = 0, ZC_KV = 512, ZC_CB = 1024, ZC_CC = 1536, ZC_CH = 2048, ZC_NQ = 2560, ZC_NK = 3328, ZC_NV = 4096, ZC_KR = 4864;
constexpr float LOG2E = 1.4426950408889634f;
constexpr float QS_MLA = 0.07216878364870323f * LOG2E;
constexpr float QS_NA = 0.08838834764831845f * LOG2E;
constexpr float DN_ALPHA = 1.4142135623730951f;
constexpr float LN_EPS = 1e-6f, RMS_EPS = 1e-6f;

constexpr size_t MiB = 1u << 20;
constexpr size_t WS_CTL = 0;
constexpr size_t WS_SSQ = 1 * MiB;
constexpr size_t WS_MOD = 2 * MiB;
constexpr size_t WS_W = 3 * MiB;
constexpr size_t W_IN = 0, W_QKV = 20 * MiB, W_O = 23 * MiB, W_GU = 31 * MiB, W_D = 75 * MiB, W_LAYER = 97 * MiB;
constexpr size_t WS_XM = WS_W + 2 * W_LAYER;
constexpr size_t WS_Z = WS_XM + 36 * MiB;
constexpr size_t WS_QKV = WS_Z + 90 * MiB;
constexpr size_t WS_H = WS_Z;
constexpr size_t WS_MIX = WS_QKV + 54 * MiB;
constexpr size_t WS_Y = WS_MIX + 36 * MiB;
constexpr size_t WS_XMID = WS_Y + 72 * MiB;
constexpr size_t WS_X1 = WS_XMID + 72 * MiB;
constexpr size_t WS_END = WS_X1 + 72 * MiB;
static_assert(WS_END <= 768 * MiB, "d_ws map");

constexpr int LDS_BYTES = 147456;
constexpr int JOB_OFF = 140 * 1024;

__device__ __forceinline__ unsigned cvt_pk_bf16(float lo, float hi) {
    typedef float f32x2_t __attribute__((ext_vector_type(2))); typedef __bf16 bf16x2_t __attribute__((ext_vector_type(2)));
    f32x2_t v = {lo, hi}; bf16x2_t b = __builtin_convertvector(v, bf16x2_t); return __builtin_bit_cast(unsigned, b);
}
__device__ __forceinline__ float bflo(unsigned w) { return __uint_as_float(w << 16); }
__device__ __forceinline__ float bfhi(unsigned w) { return __uint_as_float(w & 0xffff0000u); }
__device__ __forceinline__ u32x4 pack8(const f32x4 a, const f32x4 b) { u32x4 w; w.x = cvt_pk_bf16(a[0], a[1]); w.y = cvt_pk_bf16(a[2], a[3]); w.z = cvt_pk_bf16(b[0], b[1]); w.w = cvt_pk_bf16(b[2], b[3]); return w; }
__device__ __forceinline__ float wave_sum(float v) {
#pragma unroll
    for (int o = 1; o < 64; o <<= 1) v += __shfl_xor(v, o);
    return v;
}
#define LDS_WAIT() asm volatile("s_waitcnt lgkmcnt(0)" ::: "memory")

__device__ __forceinline__ void rope8(f32x4& v0, f32x4& v1, int fq, float pos) {
    const float sgn = (fq < 2) ? -1.f : 1.f;
    const int ib = 8 * (fq & 1);
#pragma unroll
    for (int e = 0; e < 4; ++e) {
        const float p0 = __shfl_xor(v0[e], 32), p1 = __shfl_xor(v1[e], 32);
        const float a0 = pos * __builtin_amdgcn_exp2f(-(float)(ib + e) * 0.8304820237218406f);
        const float a1 = pos * __builtin_amdgcn_exp2f(-(float)(ib + 4 + e) * 0.8304820237218406f);
        const float c0 = __cosf(a0), s0 = __sinf(a0), c1 = __cosf(a1), s1 = __sinf(a1);
        v0[e] = v0[e] * c0 + sgn * p0 * s0; v1[e] = v1[e] * c1 + sgn * p1 * s1;
    }
}

namespace pg8 {
constexpr int BM = 256, BK = 64, HALF = 128, HTB = HALF * BK * 2, STAGE_BYTES = 8 * HTB, NXCD = 8, WGM = 8;
__host__ __device__ __forceinline__ int lds_byte(int r, int c) { const int st = (r >> 4) * 2 + (c >> 5), rr = r & 15, cc = c & 31, ob = rr * 64 + cc * 2; return st * 1024 + (ob ^ (((ob >> 9) & 1) << 5)); }
__host__ __device__ __forceinline__ void stage_rc(int b, int& R, int& C) { const int st = b / 1024, sb = b % 1024, swz = sb ^ (((sb >> 9) & 1) << 5); R = (st >> 1) * 16 + swz / 64; C = (st & 1) * 32 + (swz % 64) / 2; }
__host__ __device__ __forceinline__ int perm32(int rho) { const int n = rho >> 4, i = rho & 15; return 8 * (i >> 2) + 4 * n + (i & 3); }
struct Unit { int pm, pn; };
struct Gemm { const bf16_t* A; const bf16_t* Bt; int lda, ldb, K; int split_pn, split_off; };
struct StaticOrder {
    int nM, nN, nwg, G, c;
    __device__ void init(int nM_, int nN_, int G_, int c_) { nM = nM_; nN = nN_; nwg = nM * nN; G = G_; c = c_; }
    __device__ bool next(int i, Unit& u) const {
        const long L = (long)i * G + c; if (L >= nwg) return false;
        int wgid = (int)L; { const int q = nwg / NXCD, r = nwg % NXCD, xcd = wgid % NXCD, off = wgid / NXCD; wgid = (xcd < r ? xcd * (q + 1) : r * (q + 1) + (xcd - r) * q) + off; }
        const int nig = WGM * nN, gid = wgid / nig, fm = gid * WGM, gsz = (nM - fm) < WGM ? (nM - fm) : WGM;
        u.pm = fm + ((wgid % nig) % gsz); u.pn = (wgid % nig) / gsz; return true;
    }
};
template <class Epi>
__device__ __forceinline__ void gemm_phase(LAS unsigned char* lds, const Gemm g, const StaticOrder& S, const Epi& E, const int tid) {
    const int wid = __builtin_amdgcn_readfirstlane(tid >> 6), lane = tid & 63, wr = wid >> 2, wc = wid & 3, fr = lane & 15, fq = lane >> 4;
    const int nt = g.K / BK;
    unsigned voffA[2], voffB[2];
#pragma unroll
    for (int i = 0; i < 2; ++i) { int R, C; stage_rc(tid * 16 + i * 8192, R, C); const int Rb = (R & ~31) + perm32(R & 31);
        voffA[i] = (unsigned)(R * g.lda + C) * 2u; voffB[i] = (unsigned)(Rb * g.ldb + C) * 2u; }
    const size_t kstep = (size_t)(BK * 2);
    const size_t hstepA = (size_t)HALF * g.lda * 2, hstepB = (size_t)HALF * g.ldb * 2;
    const size_t tstepA = 2 * hstepA, tstepB = 2 * hstepB;
    const unsigned ldsw = (unsigned)wid * 1024u;
    const int aoff = lds_byte(wr * 64 + fr, fq * 8), boff = lds_byte(wc * 32 + fr, fq * 8);
#define PG8_SA(b, h) (((b) * 2 + (h)) * HTB)
#define PG8_SB(b, h) ((4 + (b) * 2 + (h)) * HTB)
#define PG8_STAGE(bufoff, gbase, voff) do { _Pragma("unroll") for (int _i = 0; _i < 2; ++_i) \
        __builtin_amdgcn_global_load_lds((const unsigned*)((const char*)(gbase) + (voff)[_i]), (LAS unsigned*)(lds + (bufoff) + ldsw + _i * 8192), 16, 0, 0); } while (0)
#define PG8_LDA(dst, b, h) do { _Pragma("unroll") for (int m = 0; m < 4; ++m) _Pragma("unroll") for (int k = 0; k < 2; ++k) dst[m][k] = *(const LAS bf16x8*)(lds + PG8_SA(b, h) + aoff + m * 2048 + k * 1024); } while (0)
#define PG8_LDB(dst, b, h) do { _Pragma("unroll") for (int n = 0; n < 2; ++n) _Pragma("unroll") for (int k = 0; k < 2; ++k) dst[n][k] = *(const LAS bf16x8*)(lds + PG8_SB(b, h) + boff + n * 2048 + k * 1024); } while (0)
#define PG8_MMA(ai, bj, At, Bt) do { __builtin_amdgcn_s_setprio(1); _Pragma("unroll") for (int m = 0; m < 4; ++m) _Pragma("unroll") for (int n = 0; n < 2; ++n) _Pragma("unroll") for (int k = 0; k < 2; ++k) \
        acc[ai][bj][m][n] = __builtin_amdgcn_mfma_f32_16x16x32_bf16(Bt[n][k], At[m][k], acc[ai][bj][m][n], 0, 0, 0); __builtin_amdgcn_s_setprio(0); } while (0)
#define PG8_WAIT_V(n) asm volatile("s_waitcnt vmcnt(" #n ")" ::: "memory")
#define PG8_WAIT_L(n) asm volatile("s_waitcnt lgkmcnt(" #n ")" ::: "memory")
#define PG8_BAR __builtin_amdgcn_s_barrier()
#define PG8_SCHED __builtin_amdgcn_sched_barrier(0)
    Unit cur, nxt; int ui = 0;
    if (!S.next(0, cur)) return;
    f32x4 acc[2][2][4][2];
#pragma unroll
    for (int a = 0; a < 2; ++a)
#pragma unroll
        for (int b = 0; b < 2; ++b)
#pragma unroll
            for (int m = 0; m < 4; ++m)
#pragma unroll
                for (int n = 0; n < 2; ++n) acc[a][b][m][n] = (f32x4){0.f, 0.f, 0.f, 0.f};
    bf16x8 At[4][2], B0[2][2], B1[2][2];
    const char* cA = (const char*)g.A + (size_t)cur.pm * tstepA + (cur.pn >= g.split_pn ? g.split_off : 0); const char* cB = (const char*)g.Bt + (size_t)cur.pn * tstepB;
    PG8_STAGE(PG8_SB(0, 0), cB, voffB); PG8_STAGE(PG8_SB(0, 1), cB + hstepB, voffB); PG8_STAGE(PG8_SA(0, 0), cA, voffA); PG8_STAGE(PG8_SA(0, 1), cA + hstepA, voffA);
    if (wr == 1) PG8_BAR;
    PG8_WAIT_V(2); PG8_BAR;
    PG8_STAGE(PG8_SB(1, 0), cB + kstep, voffB); PG8_STAGE(PG8_SA(1, 0), cA + kstep, voffA); PG8_STAGE(PG8_SB(1, 1), cB + hstepB + kstep, voffB);
    PG8_WAIT_V(6); PG8_BAR;
    for (;;) {
        const bool has_next = S.next(ui + 1, nxt);
        const char* nA = has_next ? (const char*)g.A + (size_t)nxt.pm * tstepA + (nxt.pn >= g.split_pn ? g.split_off : 0) : cA; const char* nB = has_next ? (const char*)g.Bt + (size_t)nxt.pn * tstepB : cB;
        for (int t = 0; t < nt; t += 2) {
            const bool last = (t == nt - 2);
            const char* a1 = cA + (size_t)(t + 1) * kstep;
            const char* a2 = last ? nA : cA + (size_t)(t + 2) * kstep; const char* b2 = last ? nB : cB + (size_t)(t + 2) * kstep;
            const char* a3 = a2 + kstep; const char* b3 = b2 + kstep;
            PG8_LDB(B0, 0, 0); PG8_LDB(B1, 0, 1); PG8_SCHED; PG8_LDA(At, 0, 0); PG8_STAGE(PG8_SA(1, 1), a1 + hstepA, voffA);
            PG8_WAIT_V(8); PG8_WAIT_L(0); PG8_BAR; PG8_MMA(0, 0, At, B0); PG8_MMA(0, 1, At, B1); PG8_BAR; PG8_SCHED;
            PG8_LDA(At, 0, 1); PG8_STAGE(PG8_SB(0, 0), b2, voffB); PG8_STAGE(PG8_SB(0, 1), b2 + hstepB, voffB); PG8_STAGE(PG8_SA(0, 0), a2, voffA);
            PG8_WAIT_V(8); PG8_WAIT_L(0); PG8_BAR; PG8_MMA(1, 0, At, B0); PG8_MMA(1, 1, At, B1); PG8_BAR; PG8_SCHED;
            PG8_LDB(B0, 1, 0); PG8_LDB(B1, 1, 1); PG8_SCHED; PG8_LDA(At, 1, 0); PG8_STAGE(PG8_SA(0, 1), a2 + hstepA, voffA);
            PG8_WAIT_V(8); PG8_WAIT_L(0); PG8_BAR; PG8_MMA(0, 0, At, B0); PG8_MMA(0, 1, At, B1); PG8_BAR; PG8_SCHED;
            PG8_LDA(At, 1, 1); PG8_STAGE(PG8_SB(1, 0), b3, voffB); PG8_STAGE(PG8_SB(1, 1), b3 + hstepB, voffB); PG8_STAGE(PG8_SA(1, 0), a3, voffA);
            PG8_WAIT_V(8); PG8_WAIT_L(0); PG8_BAR; PG8_MMA(1, 0, At, B0); PG8_MMA(1, 1, At, B1); PG8_BAR; PG8_SCHED;
        }
        if (wr == 0) PG8_BAR;
        E(acc, cur, wr, wc, fr, fq);
        if (!has_next) break;
#pragma unroll
        for (int a = 0; a < 2; ++a)
#pragma unroll
            for (int b = 0; b < 2; ++b)
#pragma unroll
                for (int m = 0; m < 4; ++m)
#pragma unroll
                    for (int n = 0; n < 2; ++n) acc[a][b][m][n] = (f32x4){0.f, 0.f, 0.f, 0.f};
        cur = nxt; cA = nA; cB = nB; ++ui;
        if (wr == 1) PG8_BAR;
    }
    PG8_WAIT_V(0);
    PG8_BAR;
#undef PG8_SA
#undef PG8_SB
#undef PG8_STAGE
#undef PG8_LDA
#undef PG8_LDB
#undef PG8_MMA
#undef PG8_WAIT_V
#undef PG8_WAIT_L
#undef PG8_BAR
#undef PG8_SCHED
}
}
using pg8::Unit;
typedef f32x4 AccT[2][2][4][2];

struct EpiZ {
    bf16_t* Zp; float* ssq;
    __device__ __forceinline__ void operator()(const AccT& acc, const Unit& u, int wr, int wc, int fr, int fq) const {
        const int pn = u.pn, colb = pn * 256 + wc * 32 + 8 * fq;
#pragma unroll
        for (int ai = 0; ai < 2; ++ai)
#pragma unroll
            for (int m = 0; m < 4; ++m) {
                const int row = u.pm * 256 + ai * 128 + wr * 64 + m * 16 + fr;
                f32x4 a0 = acc[ai][0][m][0], a1 = acc[ai][0][m][1], b0 = acc[ai][1][m][0], b1 = acc[ai][1][m][1];
                if (pn < 4) {
                    f32x4 q = a0 * a0 + a1 * a1 + b0 * b0 + b1 * b1; float s = (q[0] + q[1]) + (q[2] + q[3]);
                    s += __shfl_xor(s, 16); s += __shfl_xor(s, 32);
                    if (fq == 0) atomicAdd(ssq + (size_t)row * 2 + (pn >> 1), s);
                } else if (pn >= 10 && pn < 13) { a0 *= QS_NA; a1 *= QS_NA; b0 *= QS_NA; b1 *= QS_NA; }
                else if (pn == 19 && wc < 2 && u.pm < 32) { const int t = row & (SEQ - 1); rope8(a0, a1, fq, (float)(wc == 0 ? (t >> 6) : (t & 63))); }
                bf16_t* p = Zp + (size_t)row * ZLD + colb;
                *(u32x4*)p = pack8(a0, a1); *(u32x4*)(p + 128) = pack8(b0, b1);
            }
    }
};
struct EpiQKV {
    bf16_t* O; const float* ssq;
    __device__ __forceinline__ void operator()(const AccT& acc, const Unit& u, int wr, int wc, int fr, int fq) const {
        const int pn = u.pn, colb = pn * 256 + wc * 32 + 8 * fq; const bool isq = pn < 6;
#pragma unroll
        for (int ai = 0; ai < 2; ++ai)
#pragma unroll
            for (int m = 0; m < 4; ++m) {
                const int row = u.pm * 256 + ai * 128 + wr * 64 + m * 16 + fr;
                float rs = __builtin_amdgcn_rsqf(ssq[(size_t)row * 2 + (isq ? 0 : 1)] * (1.0f / 512.0f) + RMS_EPS); if (isq) rs *= QS_MLA;
                f32x4 a0 = acc[ai][0][m][0] * rs, a1 = acc[ai][0][m][1] * rs, b0 = acc[ai][1][m][0] * rs, b1 = acc[ai][1][m][1] * rs;
                bf16_t* p = O + (size_t)row * QLD + colb;
                *(u32x4*)p = pack8(a0, a1);
                if (isq) {
                    if (wc < 2) { if (u.pm < 32) { const int t = row & (SEQ - 1); rope8(b0, b1, fq, (float)(wc == 0 ? (t >> 6) : (t & 63))); } *(u32x4*)(p + 128) = pack8(b0, b1); }
                } else *(u32x4*)(p + 128) = pack8(b0, b1);
            }
    }
};
struct EpiRes {
    const float* xlat; const float* xctx; const float* gate; float* Yp;
    __device__ __forceinline__ void operator()(const AccT& acc, const Unit& u, int wr, int wc, int fr, int fq) const {
        const int bidx = u.pm < 32 ? (u.pm >> 3) : 4; const float* xr = u.pm < 32 ? xlat : xctx;
        const int colb = u.pn * 256 + wc * 32 + 8 * fq;
        const float* gp = gate + (size_t)bidx * MODLD + colb;
        const f32x4 g00 = *(const f32x4*)gp, g01 = *(const f32x4*)(gp + 4), g10 = *(const f32x4*)(gp + 128), g11 = *(const f32x4*)(gp + 132);
#pragma unroll
        for (int ai = 0; ai < 2; ++ai)
#pragma unroll
            for (int m = 0; m < 4; ++m) {
                const int row = u.pm * 256 + ai * 128 + wr * 64 + m * 16 + fr;
                const float* xp = xr + (size_t)row * DM + colb; float* yp = Yp + (size_t)row * DM + colb;
                const f32x4 x00 = *(const f32x4*)xp, x01 = *(const f32x4*)(xp + 4), x10 = *(const f32x4*)(xp + 128), x11 = *(const f32x4*)(xp + 132);
                *(f32x4*)yp = x00 * DN_ALPHA + g00 * acc[ai][0][m][0]; *(f32x4*)(yp + 4) = x01 * DN_ALPHA + g01 * acc[ai][0][m][1];
                *(f32x4*)(yp + 128) = x10 * DN_ALPHA + g10 * acc[ai][1][m][0]; *(f32x4*)(yp + 132) = x11 * DN_ALPHA + g11 * acc[ai][1][m][1];
            }
    }
};
struct EpiSwiGLU {
    bf16_t* H;
    __device__ __forceinline__ void operator()(const AccT& acc, const Unit& u, int wr, int wc, int fr, int fq) const {
        const int colb = u.pn * 128 + wc * 32 + 8 * fq;
#pragma unroll
        for (int ai = 0; ai < 2; ++ai)
#pragma unroll
            for (int m = 0; m < 4; ++m) {
                const int row = u.pm * 256 + ai * 128 + wr * 64 + m * 16 + fr;
                f32x4 h0, h1;
#pragma unroll
                for (int e = 0; e < 4; ++e) {
                    const float g0 = acc[ai][0][m][0][e], g1 = acc[ai][0][m][1][e];
                    h0[e] = g0 * __builtin_amdgcn_rcpf(1.0f + __builtin_amdgcn_exp2f(-g0 * LOG2E)) * acc[ai][1][m][0][e];
                    h1[e] = g1 * __builtin_amdgcn_rcpf(1.0f + __builtin_amdgcn_exp2f(-g1 * LOG2E)) * acc[ai][1][m][1][e];
                }
                *(u32x4*)(H + (size_t)row * FF + colb) = pack8(h0, h1);
            }
    }
};

struct AttnJob {
    const bf16_t* Q; const bf16_t* Kn; const bf16_t* Kr; const bf16_t* V; bf16_t* O;
    int ldq, ldk, ldkr, ldv, ldo;
    int q0, ctx_base, nctx_tiles, lat_base, nlat_tiles;
    int R0, krow_lo; const float* rpb;
};
__device__ __forceinline__ int crow(int i, int hi) { return (i & 3) + 8 * (i >> 2) + 4 * hi; }
__device__ __forceinline__ s16x4 vtr(const LAS unsigned char* p) { return __builtin_bit_cast(s16x4, __builtin_amdgcn_ds_read_tr16_b64_v4i16((LAS s16x4*)p)); }

template <int DQK, bool NA>
__device__ __forceinline__ void attn_unit(LAS unsigned char* lds, const AttnJob& J, const int tid) {
    constexpr int KSTR = DQK * 2 + 16, VSTR = 320, KBUF = 64 * KSTR, VBUF = 64 * VSTR, NS = DQK / 16, KCH = DQK / 8, NKC = (64 * KCH) / 512;
    constexpr int BIAS_OFF = 2 * KBUF + 2 * VBUF;
    const int lane = tid & 63, l32 = lane & 31, hi = lane >> 5;
    const int wid = __builtin_amdgcn_readfirstlane(tid >> 6);
    bf16x8 qf[NS];
    { const bf16_t* qp = J.Q + (size_t)(J.q0 + wid * 32 + l32) * J.ldq + 8 * hi;
#pragma unroll
      for (int s = 0; s < NS; ++s) qf[s] = *(const bf16x8*)(qp + 16 * s); }
    LAS float* biasL = (LAS float*)(lds + BIAS_OFF);
    if (NA) { for (int i = tid; i < 15 * 31; i += 512) biasL[i] = J.rpb[i] * LOG2E; }
    const int qc = 32 * (wid & 1) + l32, c0 = min(max(qc - 8, 0), 48), qr = J.R0 + (wid >> 1), r0 = min(max(qr - 4, 0), 24);
    f32x16 O[4];
#pragma unroll
    for (int d = 0; d < 4; ++d)
#pragma unroll
        for (int i = 0; i < 16; ++i) O[d][i] = 0.f;
    float mrun = -1e30f, lsum = 0.f;
    const int nt = J.nctx_tiles + J.nlat_tiles;
    u32x4 kreg[NKC], vreg[2];
#define ATT_LOAD(t) do { const int tb_ = (t) < J.nctx_tiles ? J.ctx_base + 64 * (t) : J.lat_base + 64 * ((t) - J.nctx_tiles); \
        _Pragma("unroll") for (int i_ = 0; i_ < NKC; ++i_) { const int c_ = tid + 512 * i_, key_ = c_ / KCH, cc_ = c_ % KCH; \
            const bf16_t* src_ = (DQK == 128 || cc_ < 16) ? J.Kn + (size_t)(tb_ + key_) * J.ldk + cc_ * 8 : J.Kr + (size_t)(tb_ + key_) * J.ldkr + (cc_ - 16) * 8; kreg[i_] = *(const u32x4*)src_; } \
        _Pragma("unroll") for (int i_ = 0; i_ < 2; ++i_) { const int c_ = tid + 512 * i_, key_ = c_ >> 4, cc_ = c_ & 15; vreg[i_] = *(const u32x4*)(J.V + (size_t)(tb_ + key_) * J.ldv + cc_ * 8); } } while (0)
#define ATT_STORE(buf) do { \
        _Pragma("unroll") for (int i_ = 0; i_ < NKC; ++i_) { const int c_ = tid + 512 * i_, key_ = c_ / KCH, cc_ = c_ % KCH; *(LAS u32x4*)(lds + (buf) * KBUF + key_ * KSTR + cc_ * 16) = kreg[i_]; } \
        _Pragma("unroll") for (int i_ = 0; i_ < 2; ++i_) { const int c_ = tid + 512 * i_, key_ = c_ >> 4, cc_ = c_ & 15; *(LAS u32x4*)(lds + 2 * KBUF + (buf) * VBUF + key_ * VSTR + cc_ * 16) = vreg[i_]; } } while (0)
    ATT_LOAD(0);
    for (int t = 0; t < nt; ++t) {
        const int buf = t & 1;
        ATT_STORE(buf);
        if (t + 1 < nt) ATT_LOAD(t + 1);
        __syncthreads();
        bool active = true; int dr = 0;
        if (NA && t >= J.nctx_tiles) { const int kr = J.krow_lo + (t - J.nctx_tiles); active = (kr >= r0) && (kr < r0 + 8); dr = kr - qr + 7; }
        if (active) {
            const LAS unsigned char* Kb = lds + buf * KBUF + l32 * KSTR + 16 * hi;
            const LAS unsigned char* Vb = lds + 2 * KBUF + buf * VBUF + (4 * hi + ((lane & 15) >> 2)) * VSTR + ((lane >> 4) & 1) * 32 + (lane & 3) * 8;
            f32x16 S[2];
#pragma unroll
            for (int kb = 0; kb < 2; ++kb) {
#pragma unroll
                for (int i = 0; i < 16; ++i) S[kb][i] = 0.f;
#pragma unroll
                for (int s = 0; s < NS; ++s) { const bf16x8 kf = *(const LAS bf16x8*)(Kb + kb * 32 * KSTR + 32 * s); S[kb] = __builtin_amdgcn_mfma_f32_32x32x16_bf16(kf, qf[s], S[kb], 0, 0, 0); }
            }
            if (NA && t >= J.nctx_tiles) {
                int wb = 4 * hi - c0; asm volatile("" : "+v"(wb));
                const LAS float* brow = biasL + dr * 31 + 15 - qc + 4 * hi;
#pragma unroll
                for (int kb = 0; kb < 2; ++kb)
#pragma unroll
                    for (int i = 0; i < 16; ++i) { const int kcc = 32 * kb + (i & 3) + 8 * (i >> 2); const bool inw = (unsigned)(kcc + wb) < 16u;
                        const float bv = brow[kcc]; S[kb][i] = inw ? S[kb][i] + bv : -1e30f; }
            }
            float mx = S[0][0];
#pragma unroll
            for (int i = 1; i < 16; ++i) mx = fmaxf(mx, S[0][i]);
#pragma unroll
            for (int i = 0; i < 16; ++i) mx = fmaxf(mx, S[1][i]);
            mx = fmaxf(mx, __shfl_xor(mx, 32));
            const float mnew = fmaxf(mrun, mx), alpha = __builtin_amdgcn_exp2f(mrun - mnew); mrun = mnew;
            float ps = 0.f;
#pragma unroll
            for (int kb = 0; kb < 2; ++kb)
#pragma unroll
                for (int i = 0; i < 16; ++i) { S[kb][i] = __builtin_amdgcn_exp2f(S[kb][i] - mnew); ps += S[kb][i]; }
            lsum = lsum * alpha + ps;
#pragma unroll
            for (int d = 0; d < 4; ++d)
#pragma unroll
                for (int i = 0; i < 16; ++i) O[d][i] *= alpha;
#pragma unroll
            for (int kb = 0; kb < 2; ++kb)
#pragma unroll
                for (int s = 0; s < 2; ++s) {
                    u32x4 pw; pw.x = cvt_pk_bf16(S[kb][8 * s], S[kb][8 * s + 1]); pw.y = cvt_pk_bf16(S[kb][8 * s + 2], S[kb][8 * s + 3]); pw.z = cvt_pk_bf16(S[kb][8 * s + 4], S[kb][8 * s + 5]); pw.w = cvt_pk_bf16(S[kb][8 * s + 6], S[kb][8 * s + 7]);
                    const bf16x8 pf = __builtin_bit_cast(bf16x8, pw);
#pragma unroll
                    for (int d = 0; d < 4; ++d) {
                        const LAS unsigned char* vp = Vb + (32 * kb + 16 * s) * VSTR + d * 64;
                        const s16x4 lo = vtr(vp), hh = vtr(vp + 8 * VSTR);
                        const bf16x8 vf = __builtin_shufflevector(lo, hh, 0, 1, 2, 3, 4, 5, 6, 7);
                        O[d] = __builtin_amdgcn_mfma_f32_32x32x16_bf16(vf, pf, O[d], 0, 0, 0);
                    }
                }
        }
    }
#undef ATT_LOAD
#undef ATT_STORE
    lsum += __shfl_xor(lsum, 32);
    const float inv = 1.0f / lsum;
    bf16_t* op = J.O + (size_t)(J.q0 + wid * 32 + l32) * J.ldo + 4 * hi;
#pragma unroll
    for (int d = 0; d < 4; ++d)
#pragma unroll
        for (int j = 0; j < 4; ++j) { u32x2 w; w.x = cvt_pk_bf16(O[d][4 * j] * inv, O[d][4 * j + 1] * inv); w.y = cvt_pk_bf16(O[d][4 * j + 2] * inv, O[d][4 * j + 3] * inv);
            *(u32x2*)(op + 32 * d + 8 * j) = w; }
}

struct Args {
    const float* in[21]; float* out; unsigned char* ws; int ph_lo, ph_hi;
};
constexpr int NPHASE = 18;
#ifndef MK_EN
#define MK_EN 0xFFFF
#endif
#define EN(k) (((MK_EN) >> (k)) & 1)

__device__ __forceinline__ void transpose_item(const float* W, int N, int K, bf16_t* WT, int dst_row0, int k0, int n0, const float* kscale, LAS float* scr, int lane) {
#pragma unroll 8
    for (int i = 0; i < 32; ++i) { const int kk = 2 * i + (lane >> 5); float v = W[(size_t)(k0 + kk) * N + n0 + (lane & 31)]; if (kscale) v *= kscale[k0 + kk]; scr[kk * 33 + (lane & 31)] = v; }
    LDS_WAIT();
    const int c = lane & 7;
#pragma unroll
    for (int j = 0; j < 4; ++j) { const int n = (lane >> 3) + 8 * j; const LAS float* s = scr + (8 * c) * 33 + n;
        u32x4 o; o.x = cvt_pk_bf16(s[0 * 33], s[1 * 33]); o.y = cvt_pk_bf16(s[2 * 33], s[3 * 33]); o.z = cvt_pk_bf16(s[4 * 33], s[5 * 33]); o.w = cvt_pk_bf16(s[6 * 33], s[7 * 33]);
        *(u32x4*)(WT + (size_t)(dst_row0 + n) * K + k0 + 8 * c) = o; }
    LDS_WAIT();
}

template <bool DO_LN>
__device__ __forceinline__ void row_pass(const float* yrow, const float* lg, const float* lb, float* xout, bf16_t* xm, const float* sh, const float* sc, int lane) {
    f32x4 v[8];
#pragma unroll
    for (int j = 0; j < 8; ++j) v[j] = *(const f32x4*)(yrow + 4 * lane + 256 * j);
    if (DO_LN) {
        float s = 0.f;
#pragma unroll
        for (int j = 0; j < 8; ++j) s += (v[j][0] + v[j][1]) + (v[j][2] + v[j][3]);
        const float mean = wave_sum(s) * (1.0f / DM); float q = 0.f;
#pragma unroll
        for (int j = 0; j < 8; ++j) { v[j] = v[j] - mean; q += (v[j][0] * v[j][0] + v[j][1] * v[j][1]) + (v[j][2] * v[j][2] + v[j][3] * v[j][3]); }
        const float rstd = 1.0f / sqrtf(wave_sum(q) * (1.0f / DM) + LN_EPS);
#pragma unroll
        for (int j = 0; j < 8; ++j) { const f32x4 g = *(const f32x4*)(lg + 4 * lane + 256 * j), b = *(const f32x4*)(lb + 4 * lane + 256 * j); v[j] = v[j] * rstd * g + b; }
        if (xout) {
#pragma unroll
            for (int j = 0; j < 8; ++j) *(f32x4*)(xout + 4 * lane + 256 * j) = v[j];
        }
    }
    if (xm) {
#pragma unroll
        for (int j = 0; j < 8; ++j) { const f32x4 a = *(const f32x4*)(sc + 4 * lane + 256 * j), b = *(const f32x4*)(sh + 4 * lane + 256 * j); const f32x4 o = v[j] * (a + 1.0f) + b;
            u32x2 w; w.x = cvt_pk_bf16(o[0], o[1]); w.y = cvt_pk_bf16(o[2], o[3]); *(u32x2*)(xm + 4 * lane + 256 * j) = w; }
    }
}

typedef const __attribute__((address_space(4))) Args* KArgP;
__device__ __forceinline__ void run_phase(const int ph, LAS unsigned char* lds, const KArgP ap0, const int G, const int bx) {
        int tid = threadIdx.x; asm volatile("" : "+v"(tid));
        const int lane = tid & 63, wave = __builtin_amdgcn_readfirstlane(tid >> 6);
        KArgP ap = ap0; asm volatile("" : "+s"(ap));
        unsigned char* ws = ap->ws;
#define x_in (ap->in[0])
#define c_in (ap->in[1])
#define ctx_in (ap->in[2])
#define cctx_in (ap->in[3])
#define ada_w (ap->in[4])
#define ada_b (ap->in[5])
#define w_in (ap->in[6])
#define q_norm (ap->in[7])
#define wq_b (ap->in[8])
#define kv_norm (ap->in[9])
#define wkv_b (ap->in[10])
#define conv_w (ap->in[11])
#define na_rpb (ap->in[12])
#define w_out (ap->in[13])
#define ln1_g (ap->in[14])
#define ln1_b (ap->in[15])
#define w_gate (ap->in[16])
#define w_up (ap->in[17])
#define w_down (ap->in[18])
#define ln2_g (ap->in[19])
#define ln2_b (ap->in[20])
#define ctl ((unsigned*)(ws + WS_CTL))
#define SSQ ((float*)(ws + WS_SSQ))
#define MOD ((float*)(ws + WS_MOD))
#define XM ((bf16_t*)(ws + WS_XM))
#define Z ((bf16_t*)(ws + WS_Z))
#define QKV ((bf16_t*)(ws + WS_QKV))
#define HB ((bf16_t*)(ws + WS_H))
#define MIX ((bf16_t*)(ws + WS_MIX))
#define Y ((float*)(ws + WS_Y))
#define XMID ((float*)(ws + WS_XMID))
#define X1 ((float*)(ws + WS_X1))
        if (ph == 0) { if (EN(0)) {
            for (int i = bx * 512 + tid; i < 1024; i += G * 512) ctl[i] = 0u;
            for (int i = bx * 512 + tid; i < 2 * MTOT * 2; i += G * 512) SSQ[i] = 0.f;
            {
                LAS float* sL = (LAS float*)lds; LAS float* red = (LAS float*)(lds + 40960);
                if (bx < 192) {
                    for (int i = tid; i < 5 * DM; i += 512) { const int b = i >> 11, k = i & (DM - 1); const float v = (b < 4) ? c_in[b * DM + k] : cctx_in[k]; sL[i] = v / (1.0f + __expf(-v)); }
                    __syncthreads();
                    for (int job = bx; job < 192; job += G) {
                        const int l = job / 96, col0 = (job % 96) * 128, c4 = tid & 31, ks = tid >> 5;
                        const float* Wp = ada_w + ((size_t)l * DM + ks * 128) * MODLD + col0 + c4 * 4;
                        f32x4 a0 = {0.f, 0.f, 0.f, 0.f}, a1 = a0, a2 = a0, a3 = a0, a4 = a0;
#pragma unroll 8
                        for (int k = 0; k < 128; ++k) { const f32x4 w = *(const f32x4*)(Wp + (size_t)k * MODLD); const int kk = ks * 128 + k;
                            a0 += w * sL[kk]; a1 += w * sL[DM + kk]; a2 += w * sL[2 * DM + kk]; a3 += w * sL[3 * DM + kk]; a4 += w * sL[4 * DM + kk]; }
                        *(LAS f32x4*)(red + (ks * 5 + 0) * 128 + c4 * 4) = a0; *(LAS f32x4*)(red + (ks * 5 + 1) * 128 + c4 * 4) = a1; *(LAS f32x4*)(red + (ks * 5 + 2) * 128 + c4 * 4) = a2;
                        *(LAS f32x4*)(red + (ks * 5 + 3) * 128 + c4 * 4) = a3; *(LAS f32x4*)(red + (ks * 5 + 4) * 128 + c4 * 4) = a4;
                        __syncthreads();
                        for (int i = tid; i < 640; i += 512) { const int b = i >> 7, cc = i & 127; float s = ada_b[(size_t)l * MODLD + col0 + cc];
#pragma unroll
                            for (int k2 = 0; k2 < 16; ++k2) s += red[(k2 * 5 + b) * 128 + cc];
                            MOD[((size_t)l * 5 + b) * MODLD + col0 + cc] = s; }
                        __syncthreads();
                    }
                }
                __syncthreads();
            }
            {
                LAS float* scr = (LAS float*)(lds + wave * 16384);
                const int gw = bx * 8 + wave, NGW = G * 8;
                constexpr int I_IN = 32 * 154, I_Q = 8 * 36, I_KV = 8 * 48, I_O = 32 * 64, I_G = 32 * 176, I_D = 88 * 64, I_LAYER = I_IN + I_Q + I_KV + I_O + 2 * I_G + I_D;
                for (int it = gw; it < 2 * I_LAYER; it += NGW) {
                    const int l = it / I_LAYER; int r = it % I_LAYER;
                    unsigned char* wl = ws + WS_W + (size_t)l * W_LAYER;
                    if (r < I_IN) { const int kb = r / 154, n0 = (r % 154) * 32; const int d0 = n0 < 1024 ? n0 : (n0 < 1088 ? n0 + 3840 : n0 - 64);
                        transpose_item(w_in + (size_t)l * DM * INDIM, INDIM, DM, (bf16_t*)(wl + W_IN), d0, kb * 64, n0, nullptr, scr, lane); continue; } r -= I_IN;
                    if (r < I_Q) { const int kb = r / 36, n0 = (r % 36) * 32; const int d0 = (n0 / 192) * 256 + (n0 % 192);
                        transpose_item(wq_b + (size_t)l * 512 * 1152, 1152, 512, (bf16_t*)(wl + W_QKV), d0, kb * 64, n0, q_norm + l * 512, scr, lane); continue; } r -= I_Q;
                    if (r < I_KV) { const int kb = r / 48, n0 = (r % 48) * 32;
                        transpose_item(wkv_b + (size_t)l * 512 * 1536, 1536, 512, (bf16_t*)(wl + W_QKV), 1536 + n0, kb * 64, n0, kv_norm + l * 512, scr, lane); continue; } r -= I_KV;
                    if (r < I_O) { const int kb = r / 64, n0 = (r % 64) * 32;
                        transpose_item(w_out + (size_t)l * DM * DM, DM, DM, (bf16_t*)(wl + W_O), n0, kb * 64, n0, nullptr, scr, lane); continue; } r -= I_O;
                    if (r < I_G) { const int kb = r / 176, n0 = (r % 176) * 32; const int d0 = (n0 / 128) * 256 + (n0 % 128);
                        transpose_item(w_gate + (size_t)l * DM * FF, FF, DM, (bf16_t*)(wl + W_GU), d0, kb * 64, n0, nullptr, scr, lane); continue; } r -= I_G;
                    if (r < I_G) { const int kb = r / 176, n0 = (r % 176) * 32; const int d0 = (n0 / 128) * 256 + 128 + (n0 % 128);
                        transpose_item(w_up + (size_t)l * DM * FF, FF, DM, (bf16_t*)(wl + W_GU), d0, kb * 64, n0, nullptr, scr, lane); continue; } r -= I_G;
                    { const int kb = r / 64, n0 = (r % 64) * 32;
                        transpose_item(w_down + (size_t)l * FF * DM, DM, FF, (bf16_t*)(wl + W_D), n0, kb * 64, n0, nullptr, scr, lane); }
                }
                const u32x4 z4 = {0u, 0u, 0u, 0u};
                for (int i = bx * 512 + tid; i < 2 * (192 * 256 + 384 * 64); i += G * 512) {
                    const int l = i / (192 * 256 + 384 * 64); int r = i % (192 * 256 + 384 * 64); unsigned char* wl = ws + WS_W + (size_t)l * W_LAYER;
                    if (r < 192 * 256) { *(u32x4*)((bf16_t*)(wl + W_IN) + (size_t)(4928 + r / 256) * DM + (r % 256) * 8) = z4; }
                    else { r -= 192 * 256; const int rr = r / 64, h = rr / 64, j = rr % 64; *(u32x4*)((bf16_t*)(wl + W_QKV) + (size_t)(h * 256 + 192 + j) * 512 + (r % 64) * 8) = z4; }
                }
            }
        } } else if (ph == 1) { if (EN(1))
            for (int row = bx * 8 + wave; row < MTOT; row += G * 8) {
                const int bidx = row < NLAT ? (row >> 11) : 4; const float* src = row < NLAT ? x_in + (size_t)row * DM : ctx_in + (size_t)(row - NLAT) * DM;
                const float* mod = MOD + (size_t)bidx * MODLD;
                row_pass<false>(src, nullptr, nullptr, nullptr, XM + (size_t)row * DM, mod, mod + DM, lane);
            }
        } else {
            const int l = (ph - 2) >> 3, sub = (ph - 2) & 7; const bool last = (l == 1);
            unsigned char* wl = ws + WS_W + (size_t)l * W_LAYER;
            float* ssq = SSQ + (size_t)l * MTOT * 2;
            const float* modl = MOD + (size_t)l * 5 * MODLD;
            const int nMpost = last ? 32 : 36;
            if (sub == 0) { if (EN(2)) {
                pg8::Gemm g{XM, (const bf16_t*)(wl + W_IN), DM, DM, DM, 1 << 30, 0}; pg8::StaticOrder S; S.init(36, 20, G, bx);
                EpiZ E{Z, ssq}; pg8::gemm_phase(lds, g, S, E, tid);
            } } else if (sub == 1) { if (EN(3)) {
                pg8::Gemm g{Z + ZC_Q, (const bf16_t*)(wl + W_QKV), ZLD, 512, 512, 6, 512 * 2}; pg8::StaticOrder S; S.init(36, 12, G, bx);
                EpiQKV E{QKV, ssq}; pg8::gemm_phase(lds, g, S, E, tid);
            } } else if (sub == 2) { if (EN(4)) {
                unsigned* ctr = ctl + 64 * (1 + l);
                const int nctxq = last ? 0 : 24, nconv = last ? 128 : 144;
                const int J_NA = 192, J_MC = 384, J_NC = J_MC + nctxq, J_CV = J_NC + nctxq, J_END = J_CV + nconv;
                LAS int* jobslot = (LAS int*)(lds + JOB_OFF);
                for (;;) {
                    __syncthreads();
                    if (tid == 0) *jobslot = (int)atomicAdd(ctr, 1u);
                    __syncthreads();
                    const int job = __builtin_amdgcn_readfirstlane(*jobslot);
                    if (job >= J_END) break;
                    int tj = tid; asm volatile("" : "+v"(tj));
                    AttnJob J; J.R0 = 0; J.krow_lo = 0; J.rpb = nullptr; J.ldo = DM;
                    if (job < J_NA) {
                        const int b = job / 48, h = (job / 8) % 6, qb = job % 8;
                        J.Q = QKV + h * 256; J.ldq = QLD; J.Kn = QKV + 1536 + h * 256; J.ldk = QLD; J.Kr = Z + ZC_KR; J.ldkr = ZLD; J.V = QKV + 1536 + h * 256 + 128; J.ldv = QLD;
                        J.O = MIX + h * 128; J.q0 = b * SEQ + qb * 256; J.ctx_base = NLAT + b * CTXL; J.nctx_tiles = 4; J.lat_base = b * SEQ; J.nlat_tiles = 32;
                        if (EN(10)) attn_unit<192, false>(lds, J, tj);
                    } else if (job < J_MC) {
                        const int j = job - J_NA, b = j / 48, h = (j / 8) % 6, rb = j % 8, R0 = 4 * rb;
                        const int klo = min(max(R0 - 4, 0), 24), khi = min(max(R0 - 1, 0), 24) + 7;
                        J.Q = Z + ZC_NQ + h * 128; J.ldq = ZLD; J.Kn = Z + ZC_NK + h * 128; J.ldk = ZLD; J.Kr = nullptr; J.ldkr = 0; J.V = Z + ZC_NV + h * 128; J.ldv = ZLD;
                        J.O = MIX + 1280 + h * 128; J.q0 = b * SEQ + 256 * rb; J.ctx_base = NLAT + b * CTXL; J.nctx_tiles = 4; J.lat_base = b * SEQ + 64 * klo; J.nlat_tiles = khi - klo + 1;
                        J.R0 = R0; J.krow_lo = klo; J.rpb = na_rpb + ((size_t)l * 6 + h) * 15 * 31;
                        if (EN(11)) attn_unit<128, true>(lds, J, tj);
                    } else if (job < J_NC) {
                        const int j = job - J_MC, b = j / 6, h = j % 6;
                        J.Q = QKV + h * 256; J.ldq = QLD; J.Kn = QKV + 1536 + h * 256; J.ldk = QLD; J.Kr = Z + ZC_KR; J.ldkr = ZLD; J.V = QKV + 1536 + h * 256 + 128; J.ldv = QLD;
                        J.O = MIX + h * 128; J.q0 = NLAT + b * CTXL; J.ctx_base = NLAT + b * CTXL; J.nctx_tiles = 4; J.lat_base = 0; J.nlat_tiles = 0;
                        if (EN(10)) attn_unit<192, false>(lds, J, tj);
                    } else if (job < J_CV) {
                        const int j = job - J_NC, b = j / 6, h = j % 6;
                        J.Q = Z + ZC_NQ + h * 128; J.ldq = ZLD; J.Kn = Z + ZC_NK + h * 128; J.ldk = ZLD; J.Kr = nullptr; J.ldkr = 0; J.V = Z + ZC_NV + h * 128; J.ldv = ZLD;
                        J.O = MIX + 1280 + h * 128; J.q0 = NLAT + b * CTXL; J.ctx_base = NLAT + b * CTXL; J.nctx_tiles = 4; J.lat_base = 0; J.nlat_tiles = 0;
                        if (EN(12)) attn_unit<128, false>(lds, J, tj);
                    } else {
                        const int cj = job - J_CV; const float* cw = conv_w + (size_t)l * 3 * 512;
                        for (int it = tj; it < 64 * 64; it += 512) {
                            const int row = cj * 64 + (it >> 6), ch = (it & 63) * 8;
                            const int pos = row < NLAT ? (row & (SEQ - 1)) : ((row - NLAT) & (CTXL - 1)), len = row < NLAT ? SEQ : CTXL;
                            const bf16_t* zr = Z + (size_t)row * ZLD;
                            const u32x4 zz = {0u, 0u, 0u, 0u};
                            const u32x4 gb = *(const u32x4*)(zr + ZC_CB + ch);
                            const u32x4 c1 = *(const u32x4*)(zr + ZC_CC + ch), h1 = *(const u32x4*)(zr + ZC_CH + ch);
                            const u32x4 c0v = pos > 0 ? *(const u32x4*)(zr - ZLD + ZC_CC + ch) : zz, h0v = pos > 0 ? *(const u32x4*)(zr - ZLD + ZC_CH + ch) : zz;
                            const u32x4 c2 = pos < len - 1 ? *(const u32x4*)(zr + ZLD + ZC_CC + ch) : zz, h2 = pos < len - 1 ? *(const u32x4*)(zr + ZLD + ZC_CH + ch) : zz;
                            const f32x4 w0a = *(const f32x4*)(cw + ch), w0b = *(const f32x4*)(cw + ch + 4), w1a = *(const f32x4*)(cw + 512 + ch), w1b = *(const f32x4*)(cw + 512 + ch + 4);
                            const f32x4 w2a = *(const f32x4*)(cw + 1024 + ch), w2b = *(const f32x4*)(cw + 1024 + ch + 4);
                            u32x4 o;
#pragma unroll
                            for (int e = 0; e < 4; ++e) {
                                const float wl0 = e < 2 ? w0a[2 * e] : w0b[2 * e - 4], wh0 = e < 2 ? w0a[2 * e + 1] : w0b[2 * e - 3];
                                const float wl1 = e < 2 ? w1a[2 * e] : w1b[2 * e - 4], wh1 = e < 2 ? w1a[2 * e + 1] : w1b[2 * e - 3];
                                const float wl2 = e < 2 ? w2a[2 * e] : w2b[2 * e - 4], wh2 = e < 2 ? w2a[2 * e + 1] : w2b[2 * e - 3];
                                const float ylo = bflo(c0v[e]) * bflo(h0v[e]) * wl0 + bflo(c1[e]) * bflo(h1[e]) * wl1 + bflo(c2[e]) * bflo(h2[e]) * wl2;
                                const float yhi = bfhi(c0v[e]) * bfhi(h0v[e]) * wh0 + bfhi(c1[e]) * bfhi(h1[e]) * wh1 + bfhi(c2[e]) * bfhi(h2[e]) * wh2;
                                o[e] = cvt_pk_bf16(bflo(gb[e]) * ylo, bfhi(gb[e]) * yhi);
                            }
                            *(u32x4*)(MIX + (size_t)row * DM + 768 + ch) = o;
                        }
                    }
                }
            } } else if (sub == 3) { if (EN(5)) {
                pg8::Gemm g{MIX, (const bf16_t*)(wl + W_O), DM, DM, DM, 1 << 30, 0}; pg8::StaticOrder S; S.init(nMpost, 8, G, bx);
                EpiRes E{l == 0 ? x_in : X1, l == 0 ? ctx_in - (size_t)NLAT * DM : X1, modl + 2 * DM, Y}; pg8::gemm_phase(lds, g, S, E, tid);
            } } else if (sub == 4) { if (EN(6)) {
                for (int row = bx * 8 + wave; row < nMpost * 256; row += G * 8) {
                    const int bidx = row < NLAT ? (row >> 11) : 4; const float* mod = modl + (size_t)bidx * MODLD;
                    row_pass<true>(Y + (size_t)row * DM, ln1_g + l * DM, ln1_b + l * DM, XMID + (size_t)row * DM, XM + (size_t)row * DM, mod + 3 * DM, mod + 4 * DM, lane);
                }
            } } else if (sub == 5) { if (EN(7)) {
                pg8::Gemm g{XM, (const bf16_t*)(wl + W_GU), DM, DM, DM, 1 << 30, 0}; pg8::StaticOrder S; S.init(nMpost, 44, G, bx);
                EpiSwiGLU E{HB}; pg8::gemm_phase(lds, g, S, E, tid);
            } } else if (sub == 6) { if (EN(8)) {
                pg8::Gemm g{HB, (const bf16_t*)(wl + W_D), FF, FF, FF, 1 << 30, 0}; pg8::StaticOrder S; S.init(nMpost, 8, G, bx);
                EpiRes E{XMID, XMID, modl + 5 * DM, Y}; pg8::gemm_phase(lds, g, S, E, tid);
            } } else { if (EN(9)) {
                for (int row = bx * 8 + wave; row < nMpost * 256; row += G * 8) {
                    const int bidx = row < NLAT ? (row >> 11) : 4;
                    if (!last) { const float* mod = MOD + (size_t)(5 + bidx) * MODLD;
                        row_pass<true>(Y + (size_t)row * DM, ln2_g + l * DM, ln2_b + l * DM, X1 + (size_t)row * DM, XM + (size_t)row * DM, mod, mod + DM, lane); }
                    else row_pass<true>(Y + (size_t)row * DM, ln2_g + l * DM, ln2_b + l * DM, ap->out + (size_t)row * DM, nullptr, nullptr, nullptr, lane);
                }
            } }
        }
}
__global__ void __launch_bounds__(512, 2) mega_fwd(Args args) {
    extern __shared__ __attribute__((aligned(16))) unsigned char lds_raw[];
    LAS unsigned char* lds = (LAS unsigned char*)lds_raw;
    cg::grid_group grid = cg::this_grid();
    const int G = gridDim.x, bx = blockIdx.x;
    const KArgP ap0 = (KArgP)__builtin_amdgcn_kernarg_segment_ptr();
    const int lo = ap0->ph_lo, hi_ph = ap0->ph_hi;
#define RUN(k) if (lo <= (k) && (k) < hi_ph) { run_phase((k), lds, ap0, G, bx); if ((k) + 1 < hi_ph) grid.sync(); }
    RUN(0) RUN(1) RUN(2) RUN(3) RUN(4) RUN(5) RUN(6) RUN(7) RUN(8) RUN(9) RUN(10) RUN(11) RUN(12) RUN(13) RUN(14) RUN(15) RUN(16) RUN(17)
#undef RUN
}

#ifndef MK_PER_PHASE
#define MK_PER_PHASE 0
#endif
extern "C" void kernel_launch(void* const* d_in, const int* in_sizes, int n_in, void* d_out, int out_size, void* d_ws, size_t ws_size, hipStream_t stream) {
    static int grid = 0;
    if (grid == 0) {
        if (n_in != 21 || ws_size < WS_END) { fprintf(stderr, "kernel_launch: expected 21 inputs and >= %zu bytes of workspace; got %d, %zu\n", (size_t)WS_END, n_in, ws_size); grid = -1; return; }
        int dev = 0, cus = 0, per_cu = 0;
        (void)hipGetDevice(&dev); (void)hipDeviceGetAttribute(&cus, hipDeviceAttributeMultiprocessorCount, dev);
        if (hipFuncSetAttribute((const void*)mega_fwd, hipFuncAttributeMaxDynamicSharedMemorySize, LDS_BYTES) != hipSuccess) { fprintf(stderr, "kernel_launch: hipFuncSetAttribute failed\n"); grid = -1; return; }
        if (hipOccupancyMaxActiveBlocksPerMultiprocessor(&per_cu, (const void*)mega_fwd, 512, LDS_BYTES) != hipSuccess || per_cu < 1) { fprintf(stderr, "kernel_launch: occupancy query says %d blocks per CU\n", per_cu); per_cu = 1; }
        (void)hipGetLastError();
        grid = cus;
        if (grid > cus * per_cu) grid = cus * per_cu;
    }
    if (grid < 0) return;
    Args a{};
    for (int i = 0; i < 21; ++i) a.in[i] = (const float*)d_in[i];
    a.out = (float*)d_out; a.ws = (unsigned char*)d_ws;
#if MK_PER_PHASE
    for (int ph = 0; ph < NPHASE; ++ph) { a.ph_lo = ph; a.ph_hi = ph + 1; void* kargs[] = {&a};
        hipError_t e = hipLaunchCooperativeKernel((const void*)mega_fwd, dim3(grid), dim3(512), kargs, LDS_BYTES, stream);
        if (e != hipSuccess) { fprintf(stderr, "launch %d failed: %s\n", ph, hipGetErrorString(e)); break; } }
#else
    a.ph_lo = 0; a.ph_hi = NPHASE; void* kargs[] = {&a};
    hipError_t e = hipLaunchCooperativeKernel((const void*)mega_fwd, dim3(grid), dim3(512), kargs, LDS_BYTES, stream);
    if (e != hipSuccess) fprintf(stderr, "cooperative launch failed: %s (grid %d)\n", hipGetErrorString(e), grid);
#endif
}
```

```cpp
#include <hip/hip_runtime.h>
#include <hip/hip_cooperative_groups.h>
#include <cstdio>
#include <cstdint>
namespace cg = cooperative_groups;

#define LAS __attribute__((address_space(3)))
typedef unsigned short bf16_t;
typedef short bf16x8 __attribute__((ext_vector_type(8)));
typedef short s16x4 __attribute__((ext_vector_type(4)));
typedef float f32x4 __attribute__((ext_vector_type(4)));
typedef float f32x16 __attribute__((ext_vector_type(16)));
typedef unsigned u32x4 __attribute__((ext_vector_type(4)));
typedef unsigned u32x2 __attribute__((ext_vector_type(2)));

constexpr int DM = 2048, NBATCH = 4, SEQ = 2048, CTXL = 256, NLAT = NBATCH * SEQ, NCTX = NBATCH * CTXL, MTOT = NLAT + NCTX;
constexpr int INDIM = 4928, ZLD = 5120, QLD = 3072, FF = 5632, MODLD = 6 * DM;
constexpr int ZC_Q = 0, ZC_KV = 512, ZC_CB = 1024, ZC_CC = 1536, ZC_CH = 2048, ZC_NQ = 2560, ZC_NK = 3328, ZC_NV = 4096, ZC_KR = 4864;
constexpr float LOG2E = 1.4426950408889634f;
constexpr float QS_MLA = 0.07216878364870323f * LOG2E;
constexpr float QS_NA = 0.08838834764831845f * LOG2E;
constexpr float DN_ALPHA = 1.4142135623730951f;
constexpr float LN_EPS = 1e-6f, RMS_EPS = 1e-6f;

constexpr size_t MiB = 1u << 20;
constexpr size_t WS_CTL = 0;
constexpr size_t WS_SSQ = 1 * MiB;
constexpr size_t WS_MOD = 2 * MiB;
constexpr size_t WS_W = 3 * MiB;
constexpr size_t W_IN = 0, W_QKV = 20 * MiB, W_O = 23 * MiB, W_GU = 31 * MiB, W_D = 75 * MiB, W_LAYER = 97 * MiB;
constexpr size_t WS_XM = WS_W + 2 * W_LAYER;
constexpr size_t WS_Z = WS_XM + 36 * MiB;
constexpr size_t WS_QKV = WS_Z + 90 * MiB;
constexpr size_t WS_H = WS_Z;
constexpr size_t WS_MIX = WS_QKV + 54 * MiB;
constexpr size_t WS_Y = WS_MIX + 36 * MiB;
constexpr size_t WS_XMID = WS_Y + 72 * MiB;
constexpr size_t WS_X1 = WS_XMID + 72 * MiB;
constexpr size_t WS_END = WS_X1 + 72 * MiB;
static_assert(WS_END <= 768 * MiB, "d_ws map");

constexpr int LDS_BYTES = 147456;
constexpr int JOB_OFF = 140 * 1024;

__device__ __forceinline__ unsigned cvt_pk_bf16(float lo, float hi) {
    typedef float f32x2_t __attribute__((ext_vector_type(2))); typedef __bf16 bf16x2_t __attribute__((ext_vector_type(2)));
    f32x2_t v = {lo, hi}; bf16x2_t b = __builtin_convertvector(v, bf16x2_t); return __builtin_bit_cast(unsigned, b);
}
__device__ __forceinline__ float bflo(unsigned w) { return __uint_as_float(w << 16); }
__device__ __forceinline__ float bfhi(unsigned w) { return __uint_as_float(w & 0xffff0000u); }
__device__ __forceinline__ u32x4 pack8(const f32x4 a, const f32x4 b) { u32x4 w; w.x = cvt_pk_bf16(a[0], a[1]); w.y = cvt_pk_bf16(a[2], a[3]); w.z = cvt_pk_bf16(b[0], b[1]); w.w = cvt_pk_bf16(b[2], b[3]); return w; }
__device__ __forceinline__ float wave_sum(float v) {
#pragma unroll
    for (int o = 1; o < 64; o <<= 1) v += __shfl_xor(v, o);
    return v;
}
#define LDS_WAIT() asm volatile("s_waitcnt lgkmcnt(0)" ::: "memory")

__device__ __forceinline__ void rope8(f32x4& v0, f32x4& v1, int fq, float pos) {
    const float sgn = (fq < 2) ? -1.f : 1.f;
    const int ib = 8 * (fq & 1);
#pragma unroll
    for (int e = 0; e < 4; ++e) {
        const float p0 = __shfl_xor(v0[e], 32), p1 = __shfl_xor(v1[e], 32);
        const float a0 = pos * __builtin_amdgcn_exp2f(-(float)(ib + e) * 0.8304820237218406f);
        const float a1 = pos * __builtin_amdgcn_exp2f(-(float)(ib + 4 + e) * 0.8304820237218406f);
        const float c0 = __cosf(a0), s0 = __sinf(a0), c1 = __cosf(a1), s1 = __sinf(a1);
        v0[e] = v0[e] * c0 + sgn * p0 * s0; v1[e] = v1[e] * c1 + sgn * p1 * s1;
    }
}

namespace pg8 {
constexpr int BM = 256, BK = 64, HALF = 128, HTB = HALF * BK * 2, STAGE_BYTES = 8 * HTB, NXCD = 8, WGM = 8;
__host__ __device__ __forceinline__ int lds_byte(int r, int c) { const int st = (r >> 4) * 2 + (c >> 5), rr = r & 15, cc = c & 31, ob = rr * 64 + cc * 2; return st * 1024 + (ob ^ (((ob >> 9) & 1) << 5)); }
__host__ __device__ __forceinline__ void stage_rc(int b, int& R, int& C) { const int st = b / 1024, sb = b % 1024, swz = sb ^ (((sb >> 9) & 1) << 5); R = (st >> 1) * 16 + swz / 64; C = (st & 1) * 32 + (swz % 64) / 2; }
__host__ __device__ __forceinline__ int perm32(int rho) { const int n = rho >> 4, i = rho & 15; return 8 * (i >> 2) + 4 * n + (i & 3); }
struct Unit { int pm, pn; };
struct Gemm { const bf16_t* A; const bf16_t* Bt; int lda, ldb, K; int split_pn, split_off; };
struct StaticOrder {
    int nM, nN, nwg, G, c;
    __device__ void init(int nM_, int nN_, int G_, int c_) { nM = nM_; nN = nN_; nwg = nM * nN; G = G_; c = c_; }
    __device__ bool next(int i, Unit& u) const {
        const long L = (long)i * G + c; if (L >= nwg) return false;
        int wgid = (int)L; { const int q = nwg / NXCD, r = nwg % NXCD, xcd = wgid % NXCD, off = wgid / NXCD; wgid = (xcd < r ? xcd * (q + 1) : r * (q + 1) + (xcd - r) * q) + off; }
        const int nig = WGM * nN, gid = wgid / nig, fm = gid * WGM, gsz = (nM - fm) < WGM ? (nM - fm) : WGM;
        u.pm = fm + ((wgid % nig) % gsz); u.pn = (wgid % nig) / gsz; return true;
    }
};
template <class Epi>
__device__ __forceinline__ void gemm_phase(LAS unsigned char* lds, const Gemm g, const StaticOrder& S, const Epi& E, const int tid) {
    const int wid = __builtin_amdgcn_readfirstlane(tid >> 6), lane = tid & 63, wr = wid >> 2, wc = wid & 3, fr = lane & 15, fq = lane >> 4;
    const int nt = g.K / BK;
    unsigned voffA[2], voffB[2];
#pragma unroll
    for (int i = 0; i < 2; ++i) { int R, C; stage_rc(tid * 16 + i * 8192, R, C); const int Rb = (R & ~31) + perm32(R & 31);
        voffA[i] = (unsigned)(R * g.lda + C) * 2u; voffB[i] = (unsigned)(Rb * g.ldb + C) * 2u; }
    const size_t kstep = (size_t)(BK * 2);
    const size_t hstepA = (size_t)HALF * g.lda * 2, hstepB = (size_t)HALF * g.ldb * 2;
    const size_t tstepA = 2 * hstepA, tstepB = 2 * hstepB;
    const unsigned ldsw = (unsigned)wid * 1024u;
    const int aoff = lds_byte(wr * 64 + fr, fq * 8), boff = lds_byte(wc * 32 + fr, fq * 8);
#define PG8_SA(b, h) (((b) * 2 + (h)) * HTB)
#define PG8_SB(b, h) ((4 + (b) * 2 + (h)) * HTB)
#define PG8_STAGE(bufoff, gbase, voff) do { _Pragma("unroll") for (int _i = 0; _i < 2; ++_i) \
        __builtin_amdgcn_global_load_lds((const unsigned*)((const char*)(gbase) + (voff)[_i]), (LAS unsigned*)(lds + (bufoff) + ldsw + _i * 8192), 16, 0, 0); } while (0)
#define PG8_LDA(dst, b, h) do { _Pragma("unroll") for (int m = 0; m < 4; ++m) _Pragma("unroll") for (int k = 0; k < 2; ++k) dst[m][k] = *(const LAS bf16x8*)(lds + PG8_SA(b, h) + aoff + m * 2048 + k * 1024); } while (0)
#define PG8_LDB(dst, b, h) do { _Pragma("unroll") for (int n = 0; n < 2; ++n) _Pragma("unroll") for (int k = 0; k < 2; ++k) dst[n][k] = *(const LAS bf16x8*)(lds + PG8_SB(b, h) + boff + n * 2048 + k * 1024); } while (0)
#define PG8_MMA(ai, bj, At, Bt) do { __builtin_amdgcn_s_setprio(1); _Pragma("unroll") for (int m = 0; m < 4; ++m) _Pragma("unroll") for (int n = 0; n < 2; ++n) _Pragma("unroll") for (int k = 0; k < 2; ++k) \
        acc[ai][bj][m][n] = __builtin_amdgcn_mfma_f32_16x16x32_bf16(Bt[n][k], At[m][k], acc[ai][bj][m][n], 0, 0, 0); __builtin_amdgcn_s_setprio(0); } while (0)
#define PG8_WAIT_V(n) asm volatile("s_waitcnt vmcnt(" #n ")" ::: "memory")
#define PG8_WAIT_L(n) asm volatile("s_waitcnt lgkmcnt(" #n ")" ::: "memory")
#define PG8_BAR __builtin_amdgcn_s_barrier()
#define PG8_SCHED __builtin_amdgcn_sched_barrier(0)
    Unit cur, nxt; int ui = 0;
    if (!S.next(0, cur)) return;
    f32x4 acc[2][2][4][2];
#pragma unroll
    for (int a = 0; a < 2; ++a)
#pragma unroll
        for (int b = 0; b < 2; ++b)
#pragma unroll
            for (int m = 0; m < 4; ++m)
#pragma unroll
                for (int n = 0; n < 2; ++n) acc[a][b][m][n] = (f32x4){0.f, 0.f, 0.f, 0.f};
    bf16x8 At[4][2], B0[2][2], B1[2][2];
    const char* cA = (const char*)g.A + (size_t)cur.pm * tstepA + (cur.pn >= g.split_pn ? g.split_off : 0); const char* cB = (const char*)g.Bt + (size_t)cur.pn * tstepB;
    PG8_STAGE(PG8_SB(0, 0), cB, voffB); PG8_STAGE(PG8_SB(0, 1), cB + hstepB, voffB); PG8_STAGE(PG8_SA(0, 0), cA, voffA); PG8_STAGE(PG8_SA(0, 1), cA + hstepA, voffA);
    if (wr == 1) PG8_BAR;
    PG8_WAIT_V(2); PG8_BAR;
    PG8_STAGE(PG8_SB(1, 0), cB + kstep, voffB); PG8_STAGE(PG8_SA(1, 0), cA + kstep, voffA); PG8_STAGE(PG8_SB(1, 1), cB + hstepB + kstep, voffB);
    PG8_WAIT_V(6); PG8_BAR;
    for (;;) {
        const bool has_next = S.next(ui + 1, nxt);
        const char* nA = has_next ? (const char*)g.A + (size_t)nxt.pm * tstepA + (nxt.pn >= g.split_pn ? g.split_off : 0) : cA; const char* nB = has_next ? (const char*)g.Bt + (size_t)nxt.pn * tstepB : cB;
        for (int t = 0; t < nt; t += 2) {
            const bool last = (t == nt - 2);
            const char* a1 = cA + (size_t)(t + 1) * kstep;
            const char* a2 = last ? nA : cA + (size_t)(t + 2) * kstep; const char* b2 = last ? nB : cB + (size_t)(t + 2) * kstep;
            const char* a3 = a2 + kstep; const char* b3 = b2 + kstep;
            PG8_LDB(B0, 0, 0); PG8_LDB(B1, 0, 1); PG8_SCHED; PG8_LDA(At, 0, 0); PG8_STAGE(PG8_SA(1, 1), a1 + hstepA, voffA);
            PG8_WAIT_V(8); PG8_WAIT_L(0); PG8_BAR; PG8_MMA(0, 0, At, B0); PG8_MMA(0, 1, At, B1); PG8_BAR; PG8_SCHED;
            PG8_LDA(At, 0, 1); PG8_STAGE(PG8_SB(0, 0), b2, voffB); PG8_STAGE(PG8_SB(0, 1), b2 + hstepB, voffB); PG8_STAGE(PG8_SA(0, 0), a2, voffA);
            PG8_WAIT_V(8); PG8_WAIT_L(0); PG8_BAR; PG8_MMA(1, 0, At, B0); PG8_MMA(1, 1, At, B1); PG8_BAR; PG8_SCHED;
            PG8_LDB(B0, 1, 0); PG8_LDB(B1, 1, 1); PG8_SCHED; PG8_LDA(At, 1, 0); PG8_STAGE(PG8_SA(0, 1), a2 + hstepA, voffA);
            PG8_WAIT_V(8); PG8_WAIT_L(0); PG8_BAR; PG8_MMA(0, 0, At, B0); PG8_MMA(0, 1, At, B1); PG8_BAR; PG8_SCHED;
            PG8_LDA(At, 1, 1); PG8_STAGE(PG8_SB(1, 0), b3, voffB); PG8_STAGE(PG8_SB(1, 1), b3 + hstepB, voffB); PG8_STAGE(PG8_SA(1, 0), a3, voffA);
            PG8_WAIT_V(8); PG8_WAIT_L(0); PG8_BAR; PG8_MMA(1, 0, At, B0); PG8_MMA(1, 1, At, B1); PG8_BAR; PG8_SCHED;
        }
        if (wr == 0) PG8_BAR;
        E(acc, cur, wr, wc, fr, fq);
        if (!has_next) break;
#pragma unroll
        for (int a = 0; a < 2; ++a)
#pragma unroll
            for (int b = 0; b < 2; ++b)
#pragma unroll
                for (int m = 0; m < 4; ++m)
#pragma unroll
                    for (int n = 0; n < 2; ++n) acc[a][b][m][n] = (f32x4){0.f, 0.f, 0.f, 0.f};
        cur = nxt; cA = nA; cB = nB; ++ui;
        if (wr == 1) PG8_BAR;
    }
    PG8_WAIT_V(0);
    PG8_BAR;
#undef PG8_SA
#undef PG8_SB
#undef PG8_STAGE
#undef PG8_LDA
#undef PG8_LDB
#undef PG8_MMA
#undef PG8_WAIT_V
#undef PG8_WAIT_L
#undef PG8_BAR
#undef PG8_SCHED
}
}
using pg8::Unit;
typedef f32x4 AccT[2][2][4][2];

struct EpiZ {
    bf16_t* Zp; float* ssq;
    __device__ __forceinline__ void operator()(const AccT& acc, const Unit& u, int wr, int wc, int fr, int fq) const {
        const int pn = u.pn, colb = pn * 256 + wc * 32 + 8 * fq;
#pragma unroll
        for (int ai = 0; ai < 2; ++ai)
#pragma unroll
            for (int m = 0; m < 4; ++m) {
                const int row = u.pm * 256 + ai * 128 + wr * 64 + m * 16 + fr;
                f32x4 a0 = acc[ai][0][m][0], a1 = acc[ai][0][m][1], b0 = acc[ai][1][m][0], b1 = acc[ai][1][m][1];
                if (pn < 4) {
                    f32x4 q = a0 * a0 + a1 * a1 + b0 * b0 + b1 * b1; float s = (q[0] + q[1]) + (q[2] + q[3]);
                    s += __shfl_xor(s, 16); s += __shfl_xor(s, 32);
                    if (fq == 0) atomicAdd(ssq + (size_t)row * 2 + (pn >> 1), s);
                } else if (pn >= 10 && pn < 13) { a0 *= QS_NA; a1 *= QS_NA; b0 *= QS_NA; b1 *= QS_NA; }
                else if (pn == 19 && wc < 2 && u.pm < 32) { const int t = row & (SEQ - 1); rope8(a0, a1, fq, (float)(wc == 0 ? (t >> 6) : (t & 63))); }
                bf16_t* p = Zp + (size_t)row * ZLD + colb;
                *(u32x4*)p = pack8(a0, a1); *(u32x4*)(p + 128) = pack8(b0, b1);
            }
    }
};
struct EpiQKV {
    bf16_t* O; const float* ssq;
    __device__ __forceinline__ void operator()(const AccT& acc, const Unit& u, int wr, int wc, int fr, int fq) const {
        const int pn = u.pn, colb = pn * 256 + wc * 32 + 8 * fq; const bool isq = pn < 6;
#pragma unroll
        for (int ai = 0; ai < 2; ++ai)
#pragma unroll
            for (int m = 0; m < 4; ++m) {
                const int row = u.pm * 256 + ai * 128 + wr * 64 + m * 16 + fr;
                float rs = __builtin_amdgcn_rsqf(ssq[(size_t)row * 2 + (isq ? 0 : 1)] * (1.0f / 512.0f) + RMS_EPS); if (isq) rs *= QS_MLA;
                f32x4 a0 = acc[ai][0][m][0] * rs, a1 = acc[ai][0][m][1] * rs, b0 = acc[ai][1][m][0] * rs, b1 = acc[ai][1][m][1] * rs;
                bf16_t* p = O + (size_t)row * QLD + colb;
                *(u32x4*)p = pack8(a0, a1);
                if (isq) {
                    if (wc < 2) { if (u.pm < 32) { const int t = row & (SEQ - 1); rope8(b0, b1, fq, (float)(wc == 0 ? (t >> 6) : (t & 63))); } *(u32x4*)(p + 128) = pack8(b0, b1); }
                } else *(u32x4*)(p + 128) = pack8(b0, b1);
            }
    }
};
struct EpiRes {
    const float* xlat; const float* xctx; const float* gate; float* Yp;
    __device__ __forceinline__ void operator()(const AccT& acc, const Unit& u, int wr, int wc, int fr, int fq) const {
        const int bidx = u.pm < 32 ? (u.pm >> 3) : 4; const float* xr = u.pm < 32 ? xlat : xctx;
        const int colb = u.pn * 256 + wc * 32 + 8 * fq;
        const float* gp = gate + (size_t)bidx * MODLD + colb;
        const f32x4 g00 = *(const f32x4*)gp, g01 = *(const f32x4*)(gp + 4), g10 = *(const f32x4*)(gp + 128), g11 = *(const f32x4*)(gp + 132);
#pragma unroll
        for (int ai = 0; ai < 2; ++ai)
#pragma unroll
            for (int m = 0; m < 4; ++m) {
                const int row = u.pm * 256 + ai * 128 + wr * 64 + m * 16 + fr;
                const float* xp = xr + (size_t)row * DM + colb; float* yp = Yp + (size_t)row * DM + colb;
                const f32x4 x00 = *(const f32x4*)xp, x01 = *(const f32x4*)(xp + 4), x10 = *(const f32x4*)(xp + 128), x11 = *(const f32x4*)(xp + 132);
                *(f32x4*)yp = x00 * DN_ALPHA + g00 * acc[ai][0][m][0]; *(f32x4*)(yp + 4) = x01 * DN_ALPHA + g01 * acc[ai][0][m][1];
                *(f32x4*)(yp + 128) = x10 * DN_ALPHA + g10 * acc[ai][1][m][0]; *(f32x4*)(yp + 132) = x11 * DN_ALPHA + g11 * acc[ai][1][m][1];
            }
    }
};
struct EpiSwiGLU {
    bf16_t* H;
    __device__ __forceinline__ void operator()(const AccT& acc, const Unit& u, int wr, int wc, int fr, int fq) const {
        const int colb = u.pn * 128 + wc * 32 + 8 * fq;
#pragma unroll
        for (int ai = 0; ai < 2; ++ai)
#pragma unroll
            for (int m = 0; m < 4; ++m) {
                const int row = u.pm * 256 + ai * 128 + wr * 64 + m * 16 + fr;
                f32x4 h0, h1;
#pragma unroll
                for (int e = 0; e < 4; ++e) {
                    const float g0 = acc[ai][0][m][0][e], g1 = acc[ai][0][m][1][e];
                    h0[e] = g0 * __builtin_amdgcn_rcpf(1.0f + __builtin_amdgcn_exp2f(-g0 * LOG2E)) * acc[ai][1][m][0][e];
                    h1[e] = g1 * __builtin_amdgcn_rcpf(1.0f + __builtin_amdgcn_exp2f(-g1 * LOG2E)) * acc[ai][1][m][1][e];
                }
                *(u32x4*)(H + (size_t)row * FF + colb) = pack8(h0, h1);
            }
    }
};

struct AttnJob {
    const bf16_t* Q; const bf16_t* Kn; const bf16_t* Kr; const bf16_t* V; bf16_t* O;
    int ldq, ldk, ldkr, ldv, ldo;
    int q0, ctx_base, nctx_tiles, lat_base, nlat_tiles;
    int R0, krow_lo; const float* rpb;
};
__device__ __forceinline__ int crow(int i, int hi) { return (i & 3) + 8 * (i >> 2) + 4 * hi; }
__device__ __forceinline__ s16x4 vtr(const LAS unsigned char* p) { return __builtin_bit_cast(s16x4, __builtin_amdgcn_ds_read_tr16_b64_v4i16((LAS s16x4*)p)); }

template <int DQK, bool NA>
__device__ __forceinline__ void attn_unit(LAS unsigned char* lds, const AttnJob& J, const int tid) {
    constexpr int KSTR = DQK * 2 + 16, VSTR = 320, KBUF = 64 * KSTR, VBUF = 64 * VSTR, NS = DQK / 16, KCH = DQK / 8, NKC = (64 * KCH) / 512;
    constexpr int BIAS_OFF = 2 * KBUF + 2 * VBUF;
    const int lane = tid & 63, l32 = lane & 31, hi = lane >> 5;
    const int wid = __builtin_amdgcn_readfirstlane(tid >> 6);
    bf16x8 qf[NS];
    { const bf16_t* qp = J.Q + (size_t)(J.q0 + wid * 32 + l32) * J.ldq + 8 * hi;
#pragma unroll
      for (int s = 0; s < NS; ++s) qf[s] = *(const bf16x8*)(qp + 16 * s); }
    LAS float* biasL = (LAS float*)(lds + BIAS_OFF);
    if (NA) { for (int i = tid; i < 15 * 31; i += 512) biasL[i] = J.rpb[i] * LOG2E; }
    const int qc = 32 * (wid & 1) + l32, c0 = min(max(qc - 8, 0), 48), qr = J.R0 + (wid >> 1), r0 = min(max(qr - 4, 0), 24);
    f32x16 O[4];
#pragma unroll
    for (int d = 0; d < 4; ++d)
#pragma unroll
        for (int i = 0; i < 16; ++i) O[d][i] = 0.f;
    float mrun = -1e30f, lsum = 0.f;
    const int nt = J.nctx_tiles + J.nlat_tiles;
    u32x4 kreg[NKC], vreg[2];
#define ATT_LOAD(t) do { const int tb_ = (t) < J.nctx_tiles ? J.ctx_base + 64 * (t) : J.lat_base + 64 * ((t) - J.nctx_tiles); \
        _Pragma("unroll") for (int i_ = 0; i_ < NKC; ++i_) { const int c_ = tid + 512 * i_, key_ = c_ / KCH, cc_ = c_ % KCH; \
            const bf16_t* src_ = (DQK == 128 || cc_ < 16) ? J.Kn + (size_t)(tb_ + key_) * J.ldk + cc_ * 8 : J.Kr + (size_t)(tb_ + key_) * J.ldkr + (cc_ - 16) * 8; kreg[i_] = *(const u32x4*)src_; } \
        _Pragma("unroll") for (int i_ = 0; i_ < 2; ++i_) { const int c_ = tid + 512 * i_, key_ = c_ >> 4, cc_ = c_ & 15; vreg[i_] = *(const u32x4*)(J.V + (size_t)(tb_ + key_) * J.ldv + cc_ * 8); } } while (0)
#define ATT_STORE(buf) do { \
        _Pragma("unroll") for (int i_ = 0; i_ < NKC; ++i_) { const int c_ = tid + 512 * i_, key_ = c_ / KCH, cc_ = c_ % KCH; *(LAS u32x4*)(lds + (buf) * KBUF + key_ * KSTR + cc_ * 16) = kreg[i_]; } \
        _Pragma("unroll") for (int i_ = 0; i_ < 2; ++i_) { const int c_ = tid + 512 * i_, key_ = c_ >> 4, cc_ = c_ & 15; *(LAS u32x4*)(lds + 2 * KBUF + (buf) * VBUF + key_ * VSTR + cc_ * 16) = vreg[i_]; } } while (0)
    ATT_LOAD(0);
    for (int t = 0; t < nt; ++t) {
        const int buf = t & 1;
        ATT_STORE(buf);
        if (t + 1 < nt) ATT_LOAD(t + 1);
        __syncthreads();
        bool active = true; int dr = 0;
        if (NA && t >= J.nctx_tiles) { const int kr = J.krow_lo + (t - J.nctx_tiles); active = (kr >= r0) && (kr < r0 + 8); dr = kr - qr + 7; }
        if (active) {
            const LAS unsigned char* Kb = lds + buf * KBUF + l32 * KSTR + 16 * hi;
            const LAS unsigned char* Vb = lds + 2 * KBUF + buf * VBUF + (4 * hi + ((lane & 15) >> 2)) * VSTR + ((lane >> 4) & 1) * 32 + (lane & 3) * 8;
            f32x16 S[2];
#pragma unroll
            for (int kb = 0; kb < 2; ++kb) {
#pragma unroll
                for (int i = 0; i < 16; ++i) S[kb][i] = 0.f;
#pragma unroll
                for (int s = 0; s < NS; ++s) { const bf16x8 kf = *(const LAS bf16x8*)(Kb + kb * 32 * KSTR + 32 * s); S[kb] = __builtin_amdgcn_mfma_f32_32x32x16_bf16(kf, qf[s], S[kb], 0, 0, 0); }
            }
            if (NA && t >= J.nctx_tiles) {
                int wb = 4 * hi - c0; asm volatile("" : "+v"(wb));
                const LAS float* brow = biasL + dr * 31 + 15 - qc + 4 * hi;
#pragma unroll
                for (int kb = 0; kb < 2; ++kb)
#pragma unroll
                    for (int i = 0; i < 16; ++i) { const int kcc = 32 * kb + (i & 3) + 8 * (i >> 2); const bool inw = (unsigned)(kcc + wb) < 16u;
                        const float bv = brow[kcc]; S[kb][i] = inw ? S[kb][i] + bv : -1e30f; }
            }
            float mx = S[0][0];
#pragma unroll
            for (int i = 1; i < 16; ++i) mx = fmaxf(mx, S[0][i]);
#pragma unroll
            for (int i = 0; i < 16; ++i) mx = fmaxf(mx, S[1][i]);
            mx = fmaxf(mx, __shfl_xor(mx, 32));
            const float mnew = fmaxf(mrun, mx), alpha = __builtin_amdgcn_exp2f(mrun - mnew); mrun = mnew;
            float ps = 0.f;
#pragma unroll
            for (int kb = 0; kb < 2; ++kb)
#pragma unroll
                for (int i = 0; i < 16; ++i) { S[kb][i] = __builtin_amdgcn_exp2f(S[kb][i] - mnew); ps += S[kb][i]; }
            lsum = lsum * alpha + ps;
#pragma unroll
            for (int d = 0; d < 4; ++d)
#pragma unroll
                for (int i = 0; i < 16; ++i) O[d][i] *= alpha;
#pragma unroll
            for (int kb = 0; kb < 2; ++kb)
#pragma unroll
                for (int s = 0; s < 2; ++s) {
                    u32x4 pw; pw.x = cvt_pk_bf16(S[kb][8 * s], S[kb][8 * s + 1]); pw.y = cvt_pk_bf16(S[kb][8 * s + 2], S[kb][8 * s + 3]); pw.z = cvt_pk_bf16(S[kb][8 * s + 4], S[kb][8 * s + 5]); pw.w = cvt_pk_bf16(S[kb][8 * s + 6], S[kb][8 * s + 7]);
                    const bf16x8 pf = __builtin_bit_cast(bf16x8, pw);
#pragma unroll
                    for (int d = 0; d < 4; ++d) {
                        const LAS unsigned char* vp = Vb + (32 * kb + 16 * s) * VSTR + d * 64;
                        const s16x4 lo = vtr(vp), hh = vtr(vp + 8 * VSTR);
                        const bf16x8 vf = __builtin_shufflevector(lo, hh, 0, 1, 2, 3, 4, 5, 6, 7);
                        O[d] = __builtin_amdgcn_mfma_f32_32x32x16_bf16(vf, pf, O[d], 0, 0, 0);
                    }
                }
        }
    }
#undef ATT_LOAD
#undef ATT_STORE
    lsum += __shfl_xor(lsum, 32);
    const float inv = 1.0f / lsum;
    bf16_t* op = J.O + (size_t)(J.q0 + wid * 32 + l32) * J.ldo + 4 * hi;
#pragma unroll
    for (int d = 0; d < 4; ++d)
#pragma unroll
        for (int j = 0; j < 4; ++j) { u32x2 w; w.x = cvt_pk_bf16(O[d][4 * j] * inv, O[d][4 * j + 1] * inv); w.y = cvt_pk_bf16(O[d][4 * j + 2] * inv, O[d][4 * j + 3] * inv);
            *(u32x2*)(op + 32 * d + 8 * j) = w; }
}


#define XB_TMO      128
#define XB_XCNT(j)  (256  + 64 * (j))
#define XB_XSUB(j)  (1280 + 64 * (j))
#define XB_XGEN(j)  (2304 + 64 * (j))
#define XB_TOP      3328
#define XB_TOPGEN   3392
#define XCD_BAR_WORDS 3456
#define XB_SPIN_CAP (1u << 20)
__device__ __forceinline__ unsigned xb_ld(unsigned* p)              { return __hip_atomic_load(p, __ATOMIC_RELAXED, __HIP_MEMORY_SCOPE_AGENT); }
__device__ __forceinline__ unsigned xb_add(unsigned* p, unsigned v) { return __hip_atomic_fetch_add(p, v, __ATOMIC_RELAXED, __HIP_MEMORY_SCOPE_AGENT); }
__device__ __forceinline__ unsigned xb_xcc_id() { return (unsigned)__builtin_amdgcn_s_getreg((3 << 11) | 20) & 0xFu; }
#define XB_SPIN(cond, bar) do { unsigned _sp = 0; while (cond) { __builtin_amdgcn_s_sleep(1); \
    if ((++_sp & 255u) == 0u) { if (xb_ld(&(bar)[XB_TMO])) break; if (_sp > XB_SPIN_CAP) { atomicAdd(&(bar)[XB_TMO], 1u); break; } } } } while (0)
struct XcdBarrier { unsigned* bar; unsigned x; volatile LAS unsigned* st; };
__device__ __forceinline__ XcdBarrier xcd_barrier_post(unsigned* bar, volatile LAS unsigned* st) {
    XcdBarrier b; b.bar = bar; b.x = xb_xcc_id(); b.st = st;
    if (threadIdx.x == 0) (void)xb_add(&bar[XB_XCNT(b.x)], 1u);
    return b;
}
__device__ __forceinline__ void xcd_barrier_complete(unsigned* bar, unsigned x, unsigned& nloc, unsigned& nx) {
    const unsigned G = gridDim.x * gridDim.y * gridDim.z;
    unsigned sum, cnt, mine, sp = 0u;
    for (;;) {
        sum = 0u; cnt = 0u; mine = 0u;
#pragma unroll
        for (unsigned j = 0; j < 16; ++j) { const unsigned c = xb_ld(&bar[XB_XCNT(j)]); sum += c; cnt += (c > 0u) ? 1u : 0u; mine = (j == x) ? c : mine; }
        if (sum == G) break;
        __builtin_amdgcn_s_sleep(1);
        if ((++sp & 255u) == 0u) { if (xb_ld(&bar[XB_TMO])) break; if (sp > XB_SPIN_CAP) { atomicAdd(&bar[XB_TMO], 1u); break; } }
    }
    nloc = mine > 0u ? mine : 1u; nx = cnt > 0u ? cnt : 1u;
}
__device__ __forceinline__ void xcd_barrier(const XcdBarrier& b) {
    asm volatile("s_waitcnt vmcnt(0)" ::: "memory");
    __syncthreads();
    if (threadIdx.x == 0) {
        unsigned* bar = b.bar;
        __builtin_amdgcn_s_waitcnt(0);
        unsigned nloc = b.st[0], nx = b.st[1];
        if (nloc == 0u) { xcd_barrier_complete(bar, b.x, nloc, nx); b.st[0] = nloc; b.st[1] = nx; }
        const unsigned old = xb_add(&bar[XB_XSUB(b.x)], 1u);
        const unsigned gen = old / nloc;
        if (old + 1u == (gen + 1u) * nloc) {
            __builtin_amdgcn_fence(__ATOMIC_RELEASE, "agent");
            asm volatile("s_waitcnt vmcnt(0)" ::: "memory");
            const unsigned og = xb_add(&bar[XB_TOP], 1u);
            const unsigned tg = og / nx;
            if (og + 1u == (tg + 1u) * nx) xb_add(&bar[XB_TOPGEN], 1u);
            else XB_SPIN(xb_ld(&bar[XB_TOPGEN]) == tg, bar);
            __builtin_amdgcn_fence(__ATOMIC_ACQUIRE, "agent");
            xb_add(&bar[XB_XGEN(b.x)], 1u);
            asm volatile("s_waitcnt vmcnt(0)" ::: "memory");
        } else {
            XB_SPIN(xb_ld(&bar[XB_XGEN(b.x)]) == gen, bar);
            __builtin_amdgcn_fence(__ATOMIC_ACQUIRE, "agent");
            asm volatile("s_waitcnt vmcnt(0)" ::: "memory");
        }
    }
    __syncthreads();
}

struct Args {
    const float* in[21]; float* out; unsigned char* ws; int ph_lo, ph_hi;
};
constexpr int NPHASE = 18;
#ifndef MK_EN
#define MK_EN 0xFFFF
#endif
#define EN(k) (((MK_EN) >> (k)) & 1)

__device__ __forceinline__ void transpose_item(const float* W, int N, int K, bf16_t* WT, int dst_row0, int k0, int n0, const float* kscale, LAS float* scr, int lane) {
#pragma unroll 8
    for (int i = 0; i < 32; ++i) { const int kk = 2 * i + (lane >> 5); float v = W[(size_t)(k0 + kk) * N + n0 + (lane & 31)]; if (kscale) v *= kscale[k0 + kk]; scr[kk * 33 + (lane & 31)] = v; }
    LDS_WAIT();
    const int c = lane & 7;
#pragma unroll
    for (int j = 0; j < 4; ++j) { const int n = (lane >> 3) + 8 * j; const LAS float* s = scr + (8 * c) * 33 + n;
        u32x4 o; o.x = cvt_pk_bf16(s[0 * 33], s[1 * 33]); o.y = cvt_pk_bf16(s[2 * 33], s[3 * 33]); o.z = cvt_pk_bf16(s[4 * 33], s[5 * 33]); o.w = cvt_pk_bf16(s[6 * 33], s[7 * 33]);
        *(u32x4*)(WT + (size_t)(dst_row0 + n) * K + k0 + 8 * c) = o; }
    LDS_WAIT();
}

template <bool DO_LN>
__device__ __forceinline__ void row_pass(const float* yrow, const float* lg, const float* lb, float* xout, bf16_t* xm, const float* sh, const float* sc, int lane) {
    f32x4 v[8];
#pragma unroll
    for (int j = 0; j < 8; ++j) v[j] = *(const f32x4*)(yrow + 4 * lane + 256 * j);
    if (DO_LN) {
        float s = 0.f;
#pragma unroll
        for (int j = 0; j < 8; ++j) s += (v[j][0] + v[j][1]) + (v[j][2] + v[j][3]);
        const float mean = wave_sum(s) * (1.0f / DM); float q = 0.f;
#pragma unroll
        for (int j = 0; j < 8; ++j) { v[j] = v[j] - mean; q += (v[j][0] * v[j][0] + v[j][1] * v[j][1]) + (v[j][2] * v[j][2] + v[j][3] * v[j][3]); }
        const float rstd = 1.0f / sqrtf(wave_sum(q) * (1.0f / DM) + LN_EPS);
#pragma unroll
        for (int j = 0; j < 8; ++j) { const f32x4 g = *(const f32x4*)(lg + 4 * lane + 256 * j), b = *(const f32x4*)(lb + 4 * lane + 256 * j); v[j] = v[j] * rstd * g + b; }
        if (xout) {
#pragma unroll
            for (int j = 0; j < 8; ++j) *(f32x4*)(xout + 4 * lane + 256 * j) = v[j];
        }
    }
    if (xm) {
#pragma unroll
        for (int j = 0; j < 8; ++j) { const f32x4 a = *(const f32x4*)(sc + 4 * lane + 256 * j), b = *(const f32x4*)(sh + 4 * lane + 256 * j); const f32x4 o = v[j] * (a + 1.0f) + b;
            u32x2 w; w.x = cvt_pk_bf16(o[0], o[1]); w.y = cvt_pk_bf16(o[2], o[3]); *(u32x2*)(xm + 4 * lane + 256 * j) = w; }
    }
}

typedef const __attribute__((address_space(4))) Args* KArgP;
__device__ __forceinline__ void run_phase(const int ph, LAS unsigned char* lds, const KArgP ap0, const int G, const int bx) {
        int tid = threadIdx.x; asm volatile("" : "+v"(tid));
        const int lane = tid & 63, wave = __builtin_amdgcn_readfirstlane(tid >> 6);
        KArgP ap = ap0; asm volatile("" : "+s"(ap));
        unsigned char* ws = ap->ws;
#define x_in (ap->in[0])
#define c_in (ap->in[1])
#define ctx_in (ap->in[2])
#define cctx_in (ap->in[3])
#define ada_w (ap->in[4])
#define ada_b (ap->in[5])
#define w_in (ap->in[6])
#define q_norm (ap->in[7])
#define wq_b (ap->in[8])
#define kv_norm (ap->in[9])
#define wkv_b (ap->in[10])
#define conv_w (ap->in[11])
#define na_rpb (ap->in[12])
#define w_out (ap->in[13])
#define ln1_g (ap->in[14])
#define ln1_b (ap->in[15])
#define w_gate (ap->in[16])
#define w_up (ap->in[17])
#define w_down (ap->in[18])
#define ln2_g (ap->in[19])
#define ln2_b (ap->in[20])
#define ctl ((unsigned*)(ws + WS_CTL))
#define SSQ ((float*)(ws + WS_SSQ))
#define MOD ((float*)(ws + WS_MOD))
#define XM ((bf16_t*)(ws + WS_XM))
#define Z ((bf16_t*)(ws + WS_Z))
#define QKV ((bf16_t*)(ws + WS_QKV))
#define HB ((bf16_t*)(ws + WS_H))
#define MIX ((bf16_t*)(ws + WS_MIX))
#define Y ((float*)(ws + WS_Y))
#define XMID ((float*)(ws + WS_XMID))
#define X1 ((float*)(ws + WS_X1))
        if (ph == 0) { if (EN(0)) {
            for (int i = bx * 512 + tid; i < 8192; i += G * 512) ctl[i] = 0u;
            for (int i = bx * 512 + tid; i < 2 * MTOT * 2; i += G * 512) SSQ[i] = 0.f;
            {
                LAS float* sL = (LAS float*)lds; LAS float* red = (LAS float*)(lds + 40960);
                if (bx < 192) {
                    for (int i = tid; i < 5 * DM; i += 512) { const int b = i >> 11, k = i & (DM - 1); const float v = (b < 4) ? c_in[b * DM + k] : cctx_in[k]; sL[i] = v / (1.0f + __expf(-v)); }
                    __syncthreads();
                    for (int job = bx; job < 192; job += G) {
                        const int l = job / 96, col0 = (job % 96) * 128, c4 = tid & 31, ks = tid >> 5;
                        const float* Wp = ada_w + ((size_t)l * DM + ks * 128) * MODLD + col0 + c4 * 4;
                        f32x4 a0 = {0.f, 0.f, 0.f, 0.f}, a1 = a0, a2 = a0, a3 = a0, a4 = a0;
#pragma unroll 8
                        for (int k = 0; k < 128; ++k) { const f32x4 w = *(const f32x4*)(Wp + (size_t)k * MODLD); const int kk = ks * 128 + k;
                            a0 += w * sL[kk]; a1 += w * sL[DM + kk]; a2 += w * sL[2 * DM + kk]; a3 += w * sL[3 * DM + kk]; a4 += w * sL[4 * DM + kk]; }
                        *(LAS f32x4*)(red + (ks * 5 + 0) * 128 + c4 * 4) = a0; *(LAS f32x4*)(red + (ks * 5 + 1) * 128 + c4 * 4) = a1; *(LAS f32x4*)(red + (ks * 5 + 2) * 128 + c4 * 4) = a2;
                        *(LAS f32x4*)(red + (ks * 5 + 3) * 128 + c4 * 4) = a3; *(LAS f32x4*)(red + (ks * 5 + 4) * 128 + c4 * 4) = a4;
                        __syncthreads();
                        for (int i = tid; i < 640; i += 512) { const int b = i >> 7, cc = i & 127; float s = ada_b[(size_t)l * MODLD + col0 + cc];
#pragma unroll
                            for (int k2 = 0; k2 < 16; ++k2) s += red[(k2 * 5 + b) * 128 + cc];
                            MOD[((size_t)l * 5 + b) * MODLD + col0 + cc] = s; }
                        __syncthreads();
                    }
                }
                __syncthreads();
            }
            {
                LAS float* scr = (LAS float*)(lds + wave * 16384);
                const int gw = bx * 8 + wave, NGW = G * 8;
                constexpr int I_IN = 32 * 154, I_Q = 8 * 36, I_KV = 8 * 48, I_O = 32 * 64, I_G = 32 * 176, I_D = 88 * 64, I_LAYER = I_IN + I_Q + I_KV + I_O + 2 * I_G + I_D;
                for (int it = gw; it < 2 * I_LAYER; it += NGW) {
                    const int l = it / I_LAYER; int r = it % I_LAYER;
                    unsigned char* wl = ws + WS_W + (size_t)l * W_LAYER;
                    if (r < I_IN) { const int kb = r / 154, n0 = (r % 154) * 32; const int d0 = n0 < 1024 ? n0 : (n0 < 1088 ? n0 + 3840 : n0 - 64);
                        transpose_item(w_in + (size_t)l * DM * INDIM, INDIM, DM, (bf16_t*)(wl + W_IN), d0, kb * 64, n0, nullptr, scr, lane); continue; } r -= I_IN;
                    if (r < I_Q) { const int kb = r / 36, n0 = (r % 36) * 32; const int d0 = (n0 / 192) * 256 + (n0 % 192);
                        transpose_item(wq_b + (size_t)l * 512 * 1152, 1152, 512, (bf16_t*)(wl + W_QKV), d0, kb * 64, n0, q_norm + l * 512, scr, lane); continue; } r -= I_Q;
                    if (r < I_KV) { const int kb = r / 48, n0 = (r % 48) * 32;
                        transpose_item(wkv_b + (size_t)l * 512 * 1536, 1536, 512, (bf16_t*)(wl + W_QKV), 1536 + n0, kb * 64, n0, kv_norm + l * 512, scr, lane); continue; } r -= I_KV;
                    if (r < I_O) { const int kb = r / 64, n0 = (r % 64) * 32;
                        transpose_item(w_out + (size_t)l * DM * DM, DM, DM, (bf16_t*)(wl + W_O), n0, kb * 64, n0, nullptr, scr, lane); continue; } r -= I_O;
                    if (r < I_G) { const int kb = r / 176, n0 = (r % 176) * 32; const int d0 = (n0 / 128) * 256 + (n0 % 128);
                        transpose_item(w_gate + (size_t)l * DM * FF, FF, DM, (bf16_t*)(wl + W_GU), d0, kb * 64, n0, nullptr, scr, lane); continue; } r -= I_G;
                    if (r < I_G) { const int kb = r / 176, n0 = (r % 176) * 32; const int d0 = (n0 / 128) * 256 + 128 + (n0 % 128);
                        transpose_item(w_up + (size_t)l * DM * FF, FF, DM, (bf16_t*)(wl + W_GU), d0, kb * 64, n0, nullptr, scr, lane); continue; } r -= I_G;
                    { const int kb = r / 64, n0 = (r % 64) * 32;
                        transpose_item(w_down + (size_t)l * FF * DM, DM, FF, (bf16_t*)(wl + W_D), n0, kb * 64, n0, nullptr, scr, lane); }
                }
                const u32x4 z4 = {0u, 0u, 0u, 0u};
                for (int i = bx * 512 + tid; i < 2 * (192 * 256 + 384 * 64); i += G * 512) {
                    const int l = i / (192 * 256 + 384 * 64); int r = i % (192 * 256 + 384 * 64); unsigned char* wl = ws + WS_W + (size_t)l * W_LAYER;
                    if (r < 192 * 256) { *(u32x4*)((bf16_t*)(wl + W_IN) + (size_t)(4928 + r / 256) * DM + (r % 256) * 8) = z4; }
                    else { r -= 192 * 256; const int rr = r / 64, h = rr / 64, j = rr % 64; *(u32x4*)((bf16_t*)(wl + W_QKV) + (size_t)(h * 256 + 192 + j) * 512 + (r % 64) * 8) = z4; }
                }
            }
        } } else if (ph == 1) { if (EN(1))
            for (int row = bx * 8 + wave; row < MTOT; row += G * 8) {
                const int bidx = row < NLAT ? (row >> 11) : 4; const float* src = row < NLAT ? x_in + (size_t)row * DM : ctx_in + (size_t)(row - NLAT) * DM;
                const float* mod = MOD + (size_t)bidx * MODLD;
                row_pass<false>(src, nullptr, nullptr, nullptr, XM + (size_t)row * DM, mod, mod + DM, lane);
            }
        } else {
            const int l = (ph - 2) >> 3, sub = (ph - 2) & 7; const bool last = (l == 1);
            unsigned char* wl = ws + WS_W + (size_t)l * W_LAYER;
            float* ssq = SSQ + (size_t)l * MTOT * 2;
            const float* modl = MOD + (size_t)l * 5 * MODLD;
            const int nMpost = last ? 32 : 36;
            if (sub == 0) { if (EN(2)) {
                pg8::Gemm g{XM, (const bf16_t*)(wl + W_IN), DM, DM, DM, 1 << 30, 0}; pg8::StaticOrder S; S.init(36, 20, G, bx);
                EpiZ E{Z, ssq}; pg8::gemm_phase(lds, g, S, E, tid);
            } } else if (sub == 1) { if (EN(3)) {
                pg8::Gemm g{Z + ZC_Q, (const bf16_t*)(wl + W_QKV), ZLD, 512, 512, 6, 512 * 2}; pg8::StaticOrder S; S.init(36, 12, G, bx);
                EpiQKV E{QKV, ssq}; pg8::gemm_phase(lds, g, S, E, tid);
            } } else if (sub == 2) { if (EN(4)) {
                unsigned* ctr = ctl + 64 * (1 + l);
                const int nctxq = last ? 0 : 24, nconv = last ? 128 : 144;
                const int J_NA = 192, J_MC = 384, J_NC = J_MC + nctxq, J_CV = J_NC + nctxq, J_END = J_CV + nconv;
                LAS int* jobslot = (LAS int*)(lds + JOB_OFF);
                for (;;) {
                    __syncthreads();
                    if (tid == 0) *jobslot = (int)atomicAdd(ctr, 1u);
                    __syncthreads();
                    const int job = __builtin_amdgcn_readfirstlane(*jobslot);
                    if (job >= J_END) break;
                    int tj = tid; asm volatile("" : "+v"(tj));
                    AttnJob J; J.R0 = 0; J.krow_lo = 0; J.rpb = nullptr; J.ldo = DM;
                    if (job < J_NA) {
                        const int b = job / 48, h = (job / 8) % 6, qb = job % 8;
                        J.Q = QKV + h * 256; J.ldq = QLD; J.Kn = QKV + 1536 + h * 256; J.ldk = QLD; J.Kr = Z + ZC_KR; J.ldkr = ZLD; J.V = QKV + 1536 + h * 256 + 128; J.ldv = QLD;
                        J.O = MIX + h * 128; J.q0 = b * SEQ + qb * 256; J.ctx_base = NLAT + b * CTXL; J.nctx_tiles = 4; J.lat_base = b * SEQ; J.nlat_tiles = 32;
                        if (EN(10)) attn_unit<192, false>(lds, J, tj);
                    } else if (job < J_MC) {
                        const int j = job - J_NA, b = j / 48, h = (j / 8) % 6, rb = j % 8, R0 = 4 * rb;
                        const int klo = min(max(R0 - 4, 0), 24), khi = min(max(R0 - 1, 0), 24) + 7;
                        J.Q = Z + ZC_NQ + h * 128; J.ldq = ZLD; J.Kn = Z + ZC_NK + h * 128; J.ldk = ZLD; J.Kr = nullptr; J.ldkr = 0; J.V = Z + ZC_NV + h * 128; J.ldv = ZLD;
                        J.O = MIX + 1280 + h * 128; J.q0 = b * SEQ + 256 * rb; J.ctx_base = NLAT + b * CTXL; J.nctx_tiles = 4; J.lat_base = b * SEQ + 64 * klo; J.nlat_tiles = khi - klo + 1;
                        J.R0 = R0; J.krow_lo = klo; J.rpb = na_rpb + ((size_t)l * 6 + h) * 15 * 31;
                        if (EN(11)) attn_unit<128, true>(lds, J, tj);
                    } else if (job < J_NC) {
                        const int j = job - J_MC, b = j / 6, h = j % 6;
                        J.Q = QKV + h * 256; J.ldq = QLD; J.Kn = QKV + 1536 + h * 256; J.ldk = QLD; J.Kr = Z + ZC_KR; J.ldkr = ZLD; J.V = QKV + 1536 + h * 256 + 128; J.ldv = QLD;
                        J.O = MIX + h * 128; J.q0 = NLAT + b * CTXL; J.ctx_base = NLAT + b * CTXL; J.nctx_tiles = 4; J.lat_base = 0; J.nlat_tiles = 0;
                        if (EN(10)) attn_unit<192, false>(lds, J, tj);
                    } else if (job < J_CV) {
                        const int j = job - J_NC, b = j / 6, h = j % 6;
                        J.Q = Z + ZC_NQ + h * 128; J.ldq = ZLD; J.Kn = Z + ZC_NK + h * 128; J.ldk = ZLD; J.Kr = nullptr; J.ldkr = 0; J.V = Z + ZC_NV + h * 128; J.ldv = ZLD;
                        J.O = MIX + 1280 + h * 128; J.q0 = NLAT + b * CTXL; J.ctx_base = NLAT + b * CTXL; J.nctx_tiles = 4; J.lat_base = 0; J.nlat_tiles = 0;
                        if (EN(12)) attn_unit<128, false>(lds, J, tj);
                    } else {
                        const int cj = job - J_CV; const float* cw = conv_w + (size_t)l * 3 * 512;
                        for (int it = tj; it < 64 * 64; it += 512) {
                            const int row = cj * 64 + (it >> 6), ch = (it & 63) * 8;
                            const int pos = row < NLAT ? (row & (SEQ - 1)) : ((row - NLAT) & (CTXL - 1)), len = row < NLAT ? SEQ : CTXL;
                            const bf16_t* zr = Z + (size_t)row * ZLD;
                            const u32x4 zz = {0u, 0u, 0u, 0u};
                            const u32x4 gb = *(const u32x4*)(zr + ZC_CB + ch);
                            const u32x4 c1 = *(const u32x4*)(zr + ZC_CC + ch), h1 = *(const u32x4*)(zr + ZC_CH + ch);
                            const u32x4 c0v = pos > 0 ? *(const u32x4*)(zr - ZLD + ZC_CC + ch) : zz, h0v = pos > 0 ? *(const u32x4*)(zr - ZLD + ZC_CH + ch) : zz;
                            const u32x4 c2 = pos < len - 1 ? *(const u32x4*)(zr + ZLD + ZC_CC + ch) : zz, h2 = pos < len - 1 ? *(const u32x4*)(zr + ZLD + ZC_CH + ch) : zz;
                            const f32x4 w0a = *(const f32x4*)(cw + ch), w0b = *(const f32x4*)(cw + ch + 4), w1a = *(const f32x4*)(cw + 512 + ch), w1b = *(const f32x4*)(cw + 512 + ch + 4);
                            const f32x4 w2a = *(const f32x4*)(cw + 1024 + ch), w2b = *(const f32x4*)(cw + 1024 + ch + 4);
                            u32x4 o;
#pragma unroll
                            for (int e = 0; e < 4; ++e) {
                                const float wl0 = e < 2 ? w0a[2 * e] : w0b[2 * e - 4], wh0 = e < 2 ? w0a[2 * e + 1] : w0b[2 * e - 3];
                                const float wl1 = e < 2 ? w1a[2 * e] : w1b[2 * e - 4], wh1 = e < 2 ? w1a[2 * e + 1] : w1b[2 * e - 3];
                                const float wl2 = e < 2 ? w2a[2 * e] : w2b[2 * e - 4], wh2 = e < 2 ? w2a[2 * e + 1] : w2b[2 * e - 3];
                                const float ylo = bflo(c0v[e]) * bflo(h0v[e]) * wl0 + bflo(c1[e]) * bflo(h1[e]) * wl1 + bflo(c2[e]) * bflo(h2[e]) * wl2;
                                const float yhi = bfhi(c0v[e]) * bfhi(h0v[e]) * wh0 + bfhi(c1[e]) * bfhi(h1[e]) * wh1 + bfhi(c2[e]) * bfhi(h2[e]) * wh2;
                                o[e] = cvt_pk_bf16(bflo(gb[e]) * ylo, bfhi(gb[e]) * yhi);
                            }
                            *(u32x4*)(MIX + (size_t)row * DM + 768 + ch) = o;
                        }
                    }
                }
            } } else if (sub == 3) { if (EN(5)) {
                pg8::Gemm g{MIX, (const bf16_t*)(wl + W_O), DM, DM, DM, 1 << 30, 0}; pg8::StaticOrder S; S.init(nMpost, 8, G, bx);
                EpiRes E{l == 0 ? x_in : X1, l == 0 ? ctx_in - (size_t)NLAT * DM : X1, modl + 2 * DM, Y}; pg8::gemm_phase(lds, g, S, E, tid);
            } } else if (sub == 4) { if (EN(6)) {
                for (int row = bx * 8 + wave; row < nMpost * 256; row += G * 8) {
                    const int bidx = row < NLAT ? (row >> 11) : 4; const float* mod = modl + (size_t)bidx * MODLD;
                    row_pass<true>(Y + (size_t)row * DM, ln1_g + l * DM, ln1_b + l * DM, XMID + (size_t)row * DM, XM + (size_t)row * DM, mod + 3 * DM, mod + 4 * DM, lane);
                }
            } } else if (sub == 5) { if (EN(7)) {
                pg8::Gemm g{XM, (const bf16_t*)(wl + W_GU), DM, DM, DM, 1 << 30, 0}; pg8::StaticOrder S; S.init(nMpost, 44, G, bx);
                EpiSwiGLU E{HB}; pg8::gemm_phase(lds, g, S, E, tid);
            } } else if (sub == 6) { if (EN(8)) {
                pg8::Gemm g{HB, (const bf16_t*)(wl + W_D), FF, FF, FF, 1 << 30, 0}; pg8::StaticOrder S; S.init(nMpost, 8, G, bx);
                EpiRes E{XMID, XMID, modl + 5 * DM, Y}; pg8::gemm_phase(lds, g, S, E, tid);
            } } else { if (EN(9)) {
                for (int row = bx * 8 + wave; row < nMpost * 256; row += G * 8) {
                    const int bidx = row < NLAT ? (row >> 11) : 4;
                    if (!last) { const float* mod = MOD + (size_t)(5 + bidx) * MODLD;
                        row_pass<true>(Y + (size_t)row * DM, ln2_g + l * DM, ln2_b + l * DM, X1 + (size_t)row * DM, XM + (size_t)row * DM, mod, mod + DM, lane); }
                    else row_pass<true>(Y + (size_t)row * DM, ln2_g + l * DM, ln2_b + l * DM, ap->out + (size_t)row * DM, nullptr, nullptr, nullptr, lane);
                }
            } }
        }
}
__global__ void __launch_bounds__(512, 2) mega_fwd(Args args) {
    extern __shared__ __attribute__((aligned(16))) unsigned char lds_raw[];
    LAS unsigned char* lds = (LAS unsigned char*)lds_raw;
    cg::grid_group grid = cg::this_grid();
    const int G = gridDim.x, bx = blockIdx.x;
    const KArgP ap0 = (KArgP)__builtin_amdgcn_kernarg_segment_ptr();
    const int lo = ap0->ph_lo, hi_ph = ap0->ph_hi;
    volatile LAS unsigned* bst = (volatile LAS unsigned*)(lds + JOB_OFF + 64);
    if (threadIdx.x == 0) { bst[0] = 0u; bst[1] = 0u; }
    __syncthreads();
    XcdBarrier xb; xb.bar = (unsigned*)(ap0->ws + WS_CTL) + 4096; xb.x = 0; xb.st = bst;
#define RUN(k) if (lo <= (k) && (k) < hi_ph) { run_phase((k), lds, ap0, G, bx); if ((k) + 1 < hi_ph) { if ((k) == lo) { grid.sync(); xb = xcd_barrier_post(xb.bar, bst); } else xcd_barrier(xb); } }
    RUN(0) RUN(1) RUN(2) RUN(3) RUN(4) RUN(5) RUN(6) RUN(7) RUN(8) RUN(9) RUN(10) RUN(11) RUN(12) RUN(13) RUN(14) RUN(15) RUN(16) RUN(17)
#undef RUN
}

#ifndef MK_PER_PHASE
#define MK_PER_PHASE 0
#endif
extern "C" void kernel_launch(void* const* d_in, const int* in_sizes, int n_in, void* d_out, int out_size, void* d_ws, size_t ws_size, hipStream_t stream) {
    static int grid = 0;
    if (grid == 0) {
        if (n_in != 21 || ws_size < WS_END) { fprintf(stderr, "kernel_launch: expected 21 inputs and >= %zu bytes of workspace; got %d, %zu\n", (size_t)WS_END, n_in, ws_size); grid = -1; return; }
        int dev = 0, cus = 0, per_cu = 0;
        (void)hipGetDevice(&dev); (void)hipDeviceGetAttribute(&cus, hipDeviceAttributeMultiprocessorCount, dev);
        if (hipFuncSetAttribute((const void*)mega_fwd, hipFuncAttributeMaxDynamicSharedMemorySize, LDS_BYTES) != hipSuccess) { fprintf(stderr, "kernel_launch: hipFuncSetAttribute failed\n"); grid = -1; return; }
        if (hipOccupancyMaxActiveBlocksPerMultiprocessor(&per_cu, (const void*)mega_fwd, 512, LDS_BYTES) != hipSuccess || per_cu < 1) { fprintf(stderr, "kernel_launch: occupancy query says %d blocks per CU\n", per_cu); per_cu = 1; }
        (void)hipGetLastError();
        grid = cus;
        if (grid > cus * per_cu) grid = cus * per_cu;
    }
    if (grid < 0) return;
    Args a{};
    for (int i = 0; i < 21; ++i) a.in[i] = (const float*)d_in[i];
    a.out = (float*)d_out; a.ws = (unsigned char*)d_ws;
#if MK_PER_PHASE
    for (int ph = 0; ph < NPHASE; ++ph) { a.ph_lo = ph; a.ph_hi = ph + 1; void* kargs[] = {&a};
        hipError_t e = hipLaunchCooperativeKernel((const void*)mega_fwd, dim3(grid), dim3(512), kargs, LDS_BYTES, stream);
        if (e != hipSuccess) { fprintf(stderr, "launch %d failed: %s\n", ph, hipGetErrorString(e)); break; } }
#else
    a.ph_lo = 0; a.ph_hi = NPHASE; void* kargs[] = {&a};
    hipError_t e = hipLaunchCooperativeKernel((const void*)mega_fwd, dim3(grid), dim3(512), kargs, LDS_BYTES, stream);
    if (e != hipSuccess) fprintf(stderr, "cooperative launch failed: %s (grid %d)\n", hipGetErrorString(e), grid);
#endif
}
```

```cpp
#include <hip/hip_runtime.h>
#include <hip/hip_cooperative_groups.h>
#include <cstdio>
#include <cstdint>
namespace cg = cooperative_groups;

#define LAS __attribute__((address_space(3)))
typedef unsigned short bf16_t;
typedef short bf16x8 __attribute__((ext_vector_type(8)));
typedef short s16x4 __attribute__((ext_vector_type(4)));
typedef float f32x4 __attribute__((ext_vector_type(4)));
typedef float f32x16 __attribute__((ext_vector_type(16)));
typedef unsigned u32x4 __attribute__((ext_vector_type(4)));
typedef unsigned u32x2 __attribute__((ext_vector_type(2)));

constexpr int DM = 2048, NBATCH = 4, SEQ = 2048, CTXL = 256, NLAT = NBATCH * SEQ, NCTX = NBATCH * CTXL, MTOT = NLAT + NCTX;
constexpr int INDIM = 4928, ZLD = 5120, QLD = 3072, FF = 5632, MODLD = 6 * DM;
constexpr int ZC_Q = 0, ZC_KV = 512, ZC_CB = 1024, ZC_CC = 1536, ZC_CH = 2048, ZC_NQ = 2560, ZC_NK = 3328, ZC_NV = 4096, ZC_KR = 4864;
constexpr float LOG2E = 1.4426950408889634f;
constexpr float QS_MLA = 0.07216878364870323f * LOG2E;
constexpr float QS_NA = 0.08838834764831845f * LOG2E;
constexpr float DN_ALPHA = 1.4142135623730951f;
constexpr float LN_EPS = 1e-6f, RMS_EPS = 1e-6f;

constexpr size_t MiB = 1u << 20;
constexpr size_t WS_CTL = 0;
constexpr size_t WS_SSQ = 1 * MiB;
constexpr size_t WS_MOD = 2 * MiB;
constexpr size_t WS_W = 3 * MiB;
constexpr size_t W_IN = 0, W_QKV = 20 * MiB, W_O = 23 * MiB, W_GU = 31 * MiB, W_D = 75 * MiB, W_LAYER = 97 * MiB;
constexpr size_t WS_XM = WS_W + 2 * W_LAYER;
constexpr size_t WS_Z = WS_XM + 36 * MiB;
constexpr size_t WS_QKV = WS_Z + 90 * MiB;
constexpr size_t WS_H = WS_Z;
constexpr size_t WS_MIX = WS_QKV + 54 * MiB;
constexpr size_t WS_Y = WS_MIX + 36 * MiB;
constexpr size_t WS_XMID = WS_Y + 72 * MiB;
constexpr size_t WS_X1 = WS_XMID + 72 * MiB;
constexpr size_t WS_YS = WS_X1 + 72 * MiB;
constexpr size_t WS_END = WS_YS + 64 * MiB;
static_assert(WS_END <= 768 * MiB, "d_ws map");

constexpr int LDS_BYTES = 147456;
constexpr int JOB_OFF = 140 * 1024;

__device__ __forceinline__ unsigned cvt_pk_bf16(float lo, float hi) {
    typedef float f32x2_t __attribute__((ext_vector_type(2))); typedef __bf16 bf16x2_t __attribute__((ext_vector_type(2)));
    f32x2_t v = {lo, hi}; bf16x2_t b = __builtin_convertvector(v, bf16x2_t); return __builtin_bit_cast(unsigned, b);
}
__device__ __forceinline__ float bflo(unsigned w) { return __uint_as_float(w << 16); }
__device__ __forceinline__ float bfhi(unsigned w) { return __uint_as_float(w & 0xffff0000u); }
__device__ __forceinline__ u32x4 pack8(const f32x4 a, const f32x4 b) { u32x4 w; w.x = cvt_pk_bf16(a[0], a[1]); w.y = cvt_pk_bf16(a[2], a[3]); w.z = cvt_pk_bf16(b[0], b[1]); w.w = cvt_pk_bf16(b[2], b[3]); return w; }
__device__ __forceinline__ float wave_sum(float v) {
#pragma unroll
    for (int o = 1; o < 64; o <<= 1) v += __shfl_xor(v, o);
    return v;
}
#define LDS_WAIT() asm volatile("s_waitcnt lgkmcnt(0)" ::: "memory")

__device__ __forceinline__ void rope8(f32x4& v0, f32x4& v1, int fq, float pos) {
    const float sgn = (fq < 2) ? -1.f : 1.f;
    const int ib = 8 * (fq & 1);
#pragma unroll
    for (int e = 0; e < 4; ++e) {
        const float p0 = __shfl_xor(v0[e], 32), p1 = __shfl_xor(v1[e], 32);
        const float a0 = pos * __builtin_amdgcn_exp2f(-(float)(ib + e) * 0.8304820237218406f);
        const float a1 = pos * __builtin_amdgcn_exp2f(-(float)(ib + 4 + e) * 0.8304820237218406f);
        const float c0 = __cosf(a0), s0 = __sinf(a0), c1 = __cosf(a1), s1 = __sinf(a1);
        v0[e] = v0[e] * c0 + sgn * p0 * s0; v1[e] = v1[e] * c1 + sgn * p1 * s1;
    }
}

namespace pg8 {
constexpr int BM = 256, BK = 64, HALF = 128, HTB = HALF * BK * 2, STAGE_BYTES = 8 * HTB, NXCD = 8, WGM = 8;
__host__ __device__ __forceinline__ int lds_byte(int r, int c) { const int st = (r >> 4) * 2 + (c >> 5), rr = r & 15, cc = c & 31, ob = rr * 64 + cc * 2; return st * 1024 + (ob ^ (((ob >> 9) & 1) << 5)); }
__host__ __device__ __forceinline__ void stage_rc(int b, int& R, int& C) { const int st = b / 1024, sb = b % 1024, swz = sb ^ (((sb >> 9) & 1) << 5); R = (st >> 1) * 16 + swz / 64; C = (st & 1) * 32 + (swz % 64) / 2; }
__host__ __device__ __forceinline__ int perm32(int rho) { const int n = rho >> 4, i = rho & 15; return 8 * (i >> 2) + 4 * n + (i & 3); }
struct Unit { int pm, pn, kt0, nkt, ks; };
struct Gemm { const bf16_t* A; const bf16_t* Bt; int lda, ldb, K; int split_pn, split_off; };
struct StaticOrder {
    int nM, nN, nwg, G, c, nkt;
    __device__ void init(int nM_, int nN_, int G_, int c_, int nkt_) { nM = nM_; nN = nN_; nwg = nM * nN; G = G_; c = c_; nkt = nkt_; }
    __device__ bool map(long L, Unit& u) const {
        if (L >= nwg) return false; u.kt0 = 0; u.nkt = nkt; u.ks = 0;
        int wgid = (int)L; { const int q = nwg / NXCD, r = nwg % NXCD, xcd = wgid % NXCD, off = wgid / NXCD; wgid = (xcd < r ? xcd * (q + 1) : r * (q + 1) + (xcd - r) * q) + off; }
        const int nig = WGM * nN, gid = wgid / nig, fm = gid * WGM, gsz = (nM - fm) < WGM ? (nM - fm) : WGM;
        u.pm = fm + ((wgid % nig) % gsz); u.pn = (wgid % nig) / gsz; return true;
    }
    __device__ bool next(int i, Unit& u) const { return map((long)i * G + c, u); }
};
struct SplitOrder {
    StaticOrder lat; int nN, nk_even, nk_odd;
    __device__ void init(int nN_, int G_, int c_, int nkt_, int nk_even_, int nk_odd_) { lat.init(32, nN_, G_, c_, nkt_); nN = nN_; nk_even = nk_even_; nk_odd = nk_odd_; }
    __device__ bool next(int i, Unit& u) const {
        const long L = (long)i * lat.G + lat.c; const bool isl = L < lat.nwg;
        Unit a; (void)lat.map(isl ? L : 0, a);
        const int j = isl ? 0 : (int)(L - lat.nwg);
        const int sub = j & 7, cu = j >> 3;
        u.pn = isl ? a.pn : cu % nN; u.pm = isl ? a.pm : 32 + cu / nN; u.ks = isl ? 0 : sub;
        u.kt0 = isl ? 0 : (sub >> 1) * (nk_even + nk_odd) + (sub & 1) * nk_even; u.nkt = isl ? a.nkt : ((sub & 1) ? nk_odd : nk_even);
        return isl || j < 4 * nN * 8;
    }
};
template <class Epi, class Sched>
__device__ __forceinline__ void gemm_phase(LAS unsigned char* lds, const Gemm g, const Sched& S, const Epi& E, const int tid) {
    const int wid = __builtin_amdgcn_readfirstlane(tid >> 6), lane = tid & 63, wr = wid >> 2, wc = wid & 3, fr = lane & 15, fq = lane >> 4;
    unsigned voffA[2], voffB[2];
#pragma unroll
    for (int i = 0; i < 2; ++i) { int R, C; stage_rc(tid * 16 + i * 8192, R, C); const int Rb = (R & ~31) + perm32(R & 31);
        voffA[i] = (unsigned)(R * g.lda + C) * 2u; voffB[i] = (unsigned)(Rb * g.ldb + C) * 2u; }
    const size_t kstep = (size_t)(BK * 2);
    const size_t hstepA = (size_t)HALF * g.lda * 2, hstepB = (size_t)HALF * g.ldb * 2;
    const size_t tstepA = 2 * hstepA, tstepB = 2 * hstepB;
    const unsigned ldsw = (unsigned)wid * 1024u;
    const int aoff = lds_byte(wr * 64 + fr, fq * 8), boff = lds_byte(wc * 32 + fr, fq * 8);
#define PG8_SA(b, h) (((b) * 2 + (h)) * HTB)
#define PG8_SB(b, h) ((4 + (b) * 2 + (h)) * HTB)
#define PG8_STAGE(bufoff, gbase, voff) do { _Pragma("unroll") for (int _i = 0; _i < 2; ++_i) \
        __builtin_amdgcn_global_load_lds((const unsigned*)((const char*)(gbase) + (voff)[_i]), (LAS unsigned*)(lds + (bufoff) + ldsw + _i * 8192), 16, 0, 0); } while (0)
#define PG8_LDA(dst, b, h) do { _Pragma("unroll") for (int m = 0; m < 4; ++m) _Pragma("unroll") for (int k = 0; k < 2; ++k) dst[m][k] = *(const LAS bf16x8*)(lds + PG8_SA(b, h) + aoff + m * 2048 + k * 1024); } while (0)
#define PG8_LDB(dst, b, h) do { _Pragma("unroll") for (int n = 0; n < 2; ++n) _Pragma("unroll") for (int k = 0; k < 2; ++k) dst[n][k] = *(const LAS bf16x8*)(lds + PG8_SB(b, h) + boff + n * 2048 + k * 1024); } while (0)
#define PG8_MMA(ai, bj, At, Bt) do { __builtin_amdgcn_s_setprio(1); _Pragma("unroll") for (int m = 0; m < 4; ++m) _Pragma("unroll") for (int n = 0; n < 2; ++n) _Pragma("unroll") for (int k = 0; k < 2; ++k) \
        acc[ai][bj][m][n] = __builtin_amdgcn_mfma_f32_16x16x32_bf16(Bt[n][k], At[m][k], acc[ai][bj][m][n], 0, 0, 0); __builtin_amdgcn_s_setprio(0); } while (0)
#define PG8_WAIT_V(n) asm volatile("s_waitcnt vmcnt(" #n ")" ::: "memory")
#define PG8_WAIT_L(n) asm volatile("s_waitcnt lgkmcnt(" #n ")" ::: "memory")
#define PG8_BAR __builtin_amdgcn_s_barrier()
#define PG8_SCHED __builtin_amdgcn_sched_barrier(0)
    Unit cur, nxt; int ui = 0;
    if (!S.next(0, cur)) return;
    f32x4 acc[2][2][4][2];
#pragma unroll
    for (int a = 0; a < 2; ++a)
#pragma unroll
        for (int b = 0; b < 2; ++b)
#pragma unroll
            for (int m = 0; m < 4; ++m)
#pragma unroll
                for (int n = 0; n < 2; ++n) acc[a][b][m][n] = (f32x4){0.f, 0.f, 0.f, 0.f};
    bf16x8 At[4][2], B0[2][2], B1[2][2];
    const char* cA = (const char*)g.A + (size_t)cur.pm * tstepA + (cur.pn >= g.split_pn ? g.split_off : 0) + (size_t)cur.kt0 * kstep; const char* cB = (const char*)g.Bt + (size_t)cur.pn * tstepB + (size_t)cur.kt0 * kstep;
    PG8_STAGE(PG8_SB(0, 0), cB, voffB); PG8_STAGE(PG8_SB(0, 1), cB + hstepB, voffB); PG8_STAGE(PG8_SA(0, 0), cA, voffA); PG8_STAGE(PG8_SA(0, 1), cA + hstepA, voffA);
    if (wr == 1) PG8_BAR;
    PG8_WAIT_V(2); PG8_BAR;
    PG8_STAGE(PG8_SB(1, 0), cB + kstep, voffB); PG8_STAGE(PG8_SA(1, 0), cA + kstep, voffA); PG8_STAGE(PG8_SB(1, 1), cB + hstepB + kstep, voffB);
    PG8_WAIT_V(6); PG8_BAR;
    for (;;) {
        const bool has_next = S.next(ui + 1, nxt);
        const char* nA = has_next ? (const char*)g.A + (size_t)nxt.pm * tstepA + (nxt.pn >= g.split_pn ? g.split_off : 0) + (size_t)nxt.kt0 * kstep : cA; const char* nB = has_next ? (const char*)g.Bt + (size_t)nxt.pn * tstepB + (size_t)nxt.kt0 * kstep : cB;
        const int nt = cur.nkt;
        for (int t = 0; t < nt; t += 2) {
            const bool last = (t == nt - 2);
            const char* a1 = cA + (size_t)(t + 1) * kstep;
            const char* a2 = last ? nA : cA + (size_t)(t + 2) * kstep; const char* b2 = last ? nB : cB + (size_t)(t + 2) * kstep;
            const char* a3 = a2 + kstep; const char* b3 = b2 + kstep;
            PG8_LDB(B0, 0, 0); PG8_LDB(B1, 0, 1); PG8_SCHED; PG8_LDA(At, 0, 0); PG8_STAGE(PG8_SA(1, 1), a1 + hstepA, voffA);
            PG8_WAIT_V(8); PG8_WAIT_L(0); PG8_BAR; PG8_MMA(0, 0, At, B0); PG8_MMA(0, 1, At, B1); PG8_BAR; PG8_SCHED;
            PG8_LDA(At, 0, 1); PG8_STAGE(PG8_SB(0, 0), b2, voffB); PG8_STAGE(PG8_SB(0, 1), b2 + hstepB, voffB); PG8_STAGE(PG8_SA(0, 0), a2, voffA);
            PG8_WAIT_V(8); PG8_WAIT_L(0); PG8_BAR; PG8_MMA(1, 0, At, B0); PG8_MMA(1, 1, At, B1); PG8_BAR; PG8_SCHED;
            PG8_LDB(B0, 1, 0); PG8_LDB(B1, 1, 1); PG8_SCHED; PG8_LDA(At, 1, 0); PG8_STAGE(PG8_SA(0, 1), a2 + hstepA, voffA);
            PG8_WAIT_V(8); PG8_WAIT_L(0); PG8_BAR; PG8_MMA(0, 0, At, B0); PG8_MMA(0, 1, At, B1); PG8_BAR; PG8_SCHED;
            PG8_LDA(At, 1, 1); PG8_STAGE(PG8_SB(1, 0), b3, voffB); PG8_STAGE(PG8_SB(1, 1), b3 + hstepB, voffB); PG8_STAGE(PG8_SA(1, 0), a3, voffA);
            PG8_WAIT_V(8); PG8_WAIT_L(0); PG8_BAR; PG8_MMA(1, 0, At, B0); PG8_MMA(1, 1, At, B1); PG8_BAR; PG8_SCHED;
        }
        if (wr == 0) PG8_BAR;
        E(acc, cur, wr, wc, fr, fq);
        if (!has_next) break;
#pragma unroll
        for (int a = 0; a < 2; ++a)
#pragma unroll
            for (int b = 0; b < 2; ++b)
#pragma unroll
                for (int m = 0; m < 4; ++m)
#pragma unroll
                    for (int n = 0; n < 2; ++n) acc[a][b][m][n] = (f32x4){0.f, 0.f, 0.f, 0.f};
        cur = nxt; cA = nA; cB = nB; ++ui;
        if (wr == 1) PG8_BAR;
    }
    PG8_WAIT_V(0);
    PG8_BAR;
#undef PG8_SA
#undef PG8_SB
#undef PG8_STAGE
#undef PG8_LDA
#undef PG8_LDB
#undef PG8_MMA
#undef PG8_WAIT_V
#undef PG8_WAIT_L
#undef PG8_BAR
#undef PG8_SCHED
}
}
using pg8::Unit;
typedef f32x4 AccT[2][2][4][2];

struct EpiZ {
    bf16_t* Zp; float* ssq;
    __device__ __forceinline__ void operator()(const AccT& acc, const Unit& u, int wr, int wc, int fr, int fq) const {
        const int pn = u.pn, colb = pn * 256 + wc * 32 + 8 * fq;
#pragma unroll
        for (int ai = 0; ai < 2; ++ai)
#pragma unroll
            for (int m = 0; m < 4; ++m) {
                const int row = u.pm * 256 + ai * 128 + wr * 64 + m * 16 + fr;
                f32x4 a0 = acc[ai][0][m][0], a1 = acc[ai][0][m][1], b0 = acc[ai][1][m][0], b1 = acc[ai][1][m][1];
                if (pn < 4) {
                    f32x4 q = a0 * a0 + a1 * a1 + b0 * b0 + b1 * b1; float s = (q[0] + q[1]) + (q[2] + q[3]);
                    s += __shfl_xor(s, 16); s += __shfl_xor(s, 32);
                    if (fq == 0) atomicAdd(ssq + (size_t)row * 2 + (pn >> 1), s);
                } else if (pn >= 10 && pn < 13) { a0 *= QS_NA; a1 *= QS_NA; b0 *= QS_NA; b1 *= QS_NA; }
                else if (pn == 19 && wc < 2 && u.pm < 32) { const int t = row & (SEQ - 1); rope8(a0, a1, fq, (float)(wc == 0 ? (t >> 6) : (t & 63))); }
                bf16_t* p = Zp + (size_t)row * ZLD + colb;
                *(u32x4*)p = pack8(a0, a1); *(u32x4*)(p + 128) = pack8(b0, b1);
            }
    }
};
struct EpiQKV {
    bf16_t* O; const float* ssq;
    __device__ __forceinline__ void operator()(const AccT& acc, const Unit& u, int wr, int wc, int fr, int fq) const {
        const int pn = u.pn, colb = pn * 256 + wc * 32 + 8 * fq; const bool isq = pn < 6;
#pragma unroll
        for (int ai = 0; ai < 2; ++ai)
#pragma unroll
            for (int m = 0; m < 4; ++m) {
                const int row = u.pm * 256 + ai * 128 + wr * 64 + m * 16 + fr;
                float rs = __builtin_amdgcn_rsqf(ssq[(size_t)row * 2 + (isq ? 0 : 1)] * (1.0f / 512.0f) + RMS_EPS); if (isq) rs *= QS_MLA;
                f32x4 a0 = acc[ai][0][m][0] * rs, a1 = acc[ai][0][m][1] * rs, b0 = acc[ai][1][m][0] * rs, b1 = acc[ai][1][m][1] * rs;
                bf16_t* p = O + (size_t)row * QLD + colb;
                *(u32x4*)p = pack8(a0, a1);
                if (isq) {
                    if (wc < 2) { if (u.pm < 32) { const int t = row & (SEQ - 1); rope8(b0, b1, fq, (float)(wc == 0 ? (t >> 6) : (t & 63))); } *(u32x4*)(p + 128) = pack8(b0, b1); }
                } else *(u32x4*)(p + 128) = pack8(b0, b1);
            }
    }
};
struct EpiRes {
    const float* xlat; const float* xctx; const float* gate; float* Yp; float* YS;
    __device__ __forceinline__ void operator()(const AccT& acc, const Unit& u, int wr, int wc, int fr, int fq) const {
        const int bidx = u.pm < 32 ? (u.pm >> 3) : 4; const float* xr = u.pm < 32 ? xlat : xctx;
        const int colb = u.pn * 256 + wc * 32 + 8 * fq;
        const float* gp = gate + (size_t)bidx * MODLD + colb;
        const f32x4 g00 = *(const f32x4*)gp, g01 = *(const f32x4*)(gp + 4), g10 = *(const f32x4*)(gp + 128), g11 = *(const f32x4*)(gp + 132);
#pragma unroll
        for (int ai = 0; ai < 2; ++ai)
#pragma unroll
            for (int m = 0; m < 4; ++m) {
                const int row = u.pm * 256 + ai * 128 + wr * 64 + m * 16 + fr;
                const float* xp = xr + (size_t)row * DM + colb; float* yp = (u.pm < 32 || YS == nullptr) ? Yp + (size_t)row * DM + colb : YS + ((size_t)u.ks * NCTX + (row - NLAT)) * DM + colb;
                f32x4 x00 = {0.f, 0.f, 0.f, 0.f}, x01 = x00, x10 = x00, x11 = x00;
                if (u.kt0 == 0) { x00 = *(const f32x4*)xp; x01 = *(const f32x4*)(xp + 4); x10 = *(const f32x4*)(xp + 128); x11 = *(const f32x4*)(xp + 132); }
                *(f32x4*)yp = x00 * DN_ALPHA + g00 * acc[ai][0][m][0]; *(f32x4*)(yp + 4) = x01 * DN_ALPHA + g01 * acc[ai][0][m][1];
                *(f32x4*)(yp + 128) = x10 * DN_ALPHA + g10 * acc[ai][1][m][0]; *(f32x4*)(yp + 132) = x11 * DN_ALPHA + g11 * acc[ai][1][m][1];
            }
    }
};
struct EpiSwiGLU {
    bf16_t* H;
    __device__ __forceinline__ void operator()(const AccT& acc, const Unit& u, int wr, int wc, int fr, int fq) const {
        const int colb = u.pn * 128 + wc * 32 + 8 * fq;
#pragma unroll
        for (int ai = 0; ai < 2; ++ai)
#pragma unroll
            for (int m = 0; m < 4; ++m) {
                const int row = u.pm * 256 + ai * 128 + wr * 64 + m * 16 + fr;
                f32x4 h0, h1;
#pragma unroll
                for (int e = 0; e < 4; ++e) {
                    const float g0 = acc[ai][0][m][0][e], g1 = acc[ai][0][m][1][e];
                    h0[e] = g0 * __builtin_amdgcn_rcpf(1.0f + __builtin_amdgcn_exp2f(-g0 * LOG2E)) * acc[ai][1][m][0][e];
                    h1[e] = g1 * __builtin_amdgcn_rcpf(1.0f + __builtin_amdgcn_exp2f(-g1 * LOG2E)) * acc[ai][1][m][1][e];
                }
                *(u32x4*)(H + (size_t)row * FF + colb) = pack8(h0, h1);
            }
    }
};

struct AttnJob {
    const bf16_t* Q; const bf16_t* Kn; const bf16_t* Kr; const bf16_t* V; bf16_t* O;
    int ldq, ldk, ldkr, ldv, ldo;
    int q0, ctx_base, nctx_tiles, lat_base, nlat_tiles;
    int R0, krow_lo; const float* rpb;
};
__device__ __forceinline__ int crow(int i, int hi) { return (i & 3) + 8 * (i >> 2) + 4 * hi; }
__device__ __forceinline__ s16x4 vtr(const LAS unsigned char* p) { return __builtin_bit_cast(s16x4, __builtin_amdgcn_ds_read_tr16_b64_v4i16((LAS s16x4*)p)); }

template <int DQK, bool NA>
__device__ __forceinline__ void attn_unit(LAS unsigned char* lds, const AttnJob& J, const int tid) {
    constexpr int KSTR = DQK * 2 + 16, VSTR = 320, KBUF = 64 * KSTR, VBUF = 64 * VSTR, NS = DQK / 16, KCH = DQK / 8, NKC = (64 * KCH) / 512;
    constexpr int BIAS_OFF = 2 * KBUF + 2 * VBUF;
    const int lane = tid & 63, l32 = lane & 31, hi = lane >> 5;
    const int wid = __builtin_amdgcn_readfirstlane(tid >> 6);
    bf16x8 qf[NS];
    { const bf16_t* qp = J.Q + (size_t)(J.q0 + wid * 32 + l32) * J.ldq + 8 * hi;
#pragma unroll
      for (int s = 0; s < NS; ++s) qf[s] = *(const bf16x8*)(qp + 16 * s); }
    LAS float* biasL = (LAS float*)(lds + BIAS_OFF);
    if (NA) { for (int i = tid; i < 15 * 31; i += 512) biasL[i] = J.rpb[i] * LOG2E; }
    const int qc = 32 * (wid & 1) + l32, c0 = min(max(qc - 8, 0), 48), qr = J.R0 + (wid >> 1), r0 = min(max(qr - 4, 0), 24);
    f32x16 O[4];
#pragma unroll
    for (int d = 0; d < 4; ++d)
#pragma unroll
        for (int i = 0; i < 16; ++i) O[d][i] = 0.f;
    float mrun = -1e30f, lsum = 0.f;
    const int nt = J.nctx_tiles + J.nlat_tiles;
    u32x4 kreg[NKC], vreg[2];
#define ATT_LOAD(t) do { const int tb_ = (t) < J.nctx_tiles ? J.ctx_base + 64 * (t) : J.lat_base + 64 * ((t) - J.nctx_tiles); \
        _Pragma("unroll") for (int i_ = 0; i_ < NKC; ++i_) { const int c_ = tid + 512 * i_, key_ = c_ / KCH, cc_ = c_ % KCH; \
            const bf16_t* src_ = (DQK == 128 || cc_ < 16) ? J.Kn + (size_t)(tb_ + key_) * J.ldk + cc_ * 8 : J.Kr + (size_t)(tb_ + key_) * J.ldkr + (cc_ - 16) * 8; kreg[i_] = *(const u32x4*)src_; } \
        _Pragma("unroll") for (int i_ = 0; i_ < 2; ++i_) { const int c_ = tid + 512 * i_, key_ = c_ >> 4, cc_ = c_ & 15; vreg[i_] = *(const u32x4*)(J.V + (size_t)(tb_ + key_) * J.ldv + cc_ * 8); } } while (0)
#define ATT_STORE(buf) do { \
        _Pragma("unroll") for (int i_ = 0; i_ < NKC; ++i_) { const int c_ = tid + 512 * i_, key_ = c_ / KCH, cc_ = c_ % KCH; *(LAS u32x4*)(lds + (buf) * KBUF + key_ * KSTR + cc_ * 16) = kreg[i_]; } \
        _Pragma("unroll") for (int i_ = 0; i_ < 2; ++i_) { const int c_ = tid + 512 * i_, key_ = c_ >> 4, cc_ = c_ & 15; *(LAS u32x4*)(lds + 2 * KBUF + (buf) * VBUF + key_ * VSTR + cc_ * 16) = vreg[i_]; } } while (0)
    ATT_LOAD(0);
    for (int t = 0; t < nt; ++t) {
        const int buf = t & 1;
        ATT_STORE(buf);
        if (t + 1 < nt) ATT_LOAD(t + 1);
        __syncthreads();
        bool active = true; int dr = 0;
        if (NA && t >= J.nctx_tiles) { const int kr = J.krow_lo + (t - J.nctx_tiles); active = (kr >= r0) && (kr < r0 + 8); dr = kr - qr + 7; }
        if (active) {
            const LAS unsigned char* Kb = lds + buf * KBUF + l32 * KSTR + 16 * hi;
            const LAS unsigned char* Vb = lds + 2 * KBUF + buf * VBUF + (4 * hi + ((lane & 15) >> 2)) * VSTR + ((lane >> 4) & 1) * 32 + (lane & 3) * 8;
            f32x16 S[2];
#pragma unroll
            for (int kb = 0; kb < 2; ++kb) {
#pragma unroll
                for (int i = 0; i < 16; ++i) S[kb][i] = 0.f;
#pragma unroll
                for (int s = 0; s < NS; ++s) { const bf16x8 kf = *(const LAS bf16x8*)(Kb + kb * 32 * KSTR + 32 * s); S[kb] = __builtin_amdgcn_mfma_f32_32x32x16_bf16(kf, qf[s], S[kb], 0, 0, 0); }
            }
            if (NA && t >= J.nctx_tiles) {
                int wb = 4 * hi - c0; asm volatile("" : "+v"(wb));
                const LAS float* brow = biasL + dr * 31 + 15 - qc + 4 * hi;
#pragma unroll
                for (int kb = 0; kb < 2; ++kb)
#pragma unroll
                    for (int i = 0; i < 16; ++i) { const int kcc = 32 * kb + (i & 3) + 8 * (i >> 2); const bool inw = (unsigned)(kcc + wb) < 16u;
                        const float bv = brow[kcc]; S[kb][i] = inw ? S[kb][i] + bv : -1e30f; }
            }
            float mx = S[0][0];
#pragma unroll
            for (int i = 1; i < 16; ++i) mx = fmaxf(mx, S[0][i]);
#pragma unroll
            for (int i = 0; i < 16; ++i) mx = fmaxf(mx, S[1][i]);
            mx = fmaxf(mx, __shfl_xor(mx, 32));
            const float mnew = fmaxf(mrun, mx), alpha = __builtin_amdgcn_exp2f(mrun - mnew); mrun = mnew;
            float ps = 0.f;
#pragma unroll
            for (int kb = 0; kb < 2; ++kb)
#pragma unroll
                for (int i = 0; i < 16; ++i) { S[kb][i] = __builtin_amdgcn_exp2f(S[kb][i] - mnew); ps += S[kb][i]; }
            lsum = lsum * alpha + ps;
#pragma unroll
            for (int d = 0; d < 4; ++d)
#pragma unroll
                for (int i = 0; i < 16; ++i) O[d][i] *= alpha;
#pragma unroll
            for (int kb = 0; kb < 2; ++kb)
#pragma unroll
                for (int s = 0; s < 2; ++s) {
                    u32x4 pw; pw.x = cvt_pk_bf16(S[kb][8 * s], S[kb][8 * s + 1]); pw.y = cvt_pk_bf16(S[kb][8 * s + 2], S[kb][8 * s + 3]); pw.z = cvt_pk_bf16(S[kb][8 * s + 4], S[kb][8 * s + 5]); pw.w = cvt_pk_bf16(S[kb][8 * s + 6], S[kb][8 * s + 7]);
                    const bf16x8 pf = __builtin_bit_cast(bf16x8, pw);
#pragma unroll
                    for (int d = 0; d < 4; ++d) {
                        const LAS unsigned char* vp = Vb + (32 * kb + 16 * s) * VSTR + d * 64;
                        const s16x4 lo = vtr(vp), hh = vtr(vp + 8 * VSTR);
                        const bf16x8 vf = __builtin_shufflevector(lo, hh, 0, 1, 2, 3, 4, 5, 6, 7);
                        O[d] = __builtin_amdgcn_mfma_f32_32x32x16_bf16(vf, pf, O[d], 0, 0, 0);
                    }
                }
        }
    }
#undef ATT_LOAD
#undef ATT_STORE
    lsum += __shfl_xor(lsum, 32);
    const float inv = 1.0f / lsum;
    bf16_t* op = J.O + (size_t)(J.q0 + wid * 32 + l32) * J.ldo + 4 * hi;
#pragma unroll
    for (int d = 0; d < 4; ++d)
#pragma unroll
        for (int j = 0; j < 4; ++j) { u32x2 w; w.x = cvt_pk_bf16(O[d][4 * j] * inv, O[d][4 * j + 1] * inv); w.y = cvt_pk_bf16(O[d][4 * j + 2] * inv, O[d][4 * j + 3] * inv);
            *(u32x2*)(op + 32 * d + 8 * j) = w; }
}


#define XB_TMO      128
#define XB_XCNT(j)  (256  + 64 * (j))
#define XB_XSUB(j)  (1280 + 64 * (j))
#define XB_XGEN(j)  (2304 + 64 * (j))
#define XB_TOP      3328
#define XB_TOPGEN   3392
#define XCD_BAR_WORDS 3456
#define XB_SPIN_CAP (1u << 20)
__device__ __forceinline__ unsigned xb_ld(unsigned* p)              { return __hip_atomic_load(p, __ATOMIC_RELAXED, __HIP_MEMORY_SCOPE_AGENT); }
__device__ __forceinline__ unsigned xb_add(unsigned* p, unsigned v) { return __hip_atomic_fetch_add(p, v, __ATOMIC_RELAXED, __HIP_MEMORY_SCOPE_AGENT); }
__device__ __forceinline__ unsigned xb_xcc_id() { return (unsigned)__builtin_amdgcn_s_getreg((3 << 11) | 20) & 0xFu; }
#define XB_SPIN(cond, bar) do { unsigned _sp = 0; while (cond) { __builtin_amdgcn_s_sleep(1); \
    if ((++_sp & 255u) == 0u) { if (xb_ld(&(bar)[XB_TMO])) break; if (_sp > XB_SPIN_CAP) { atomicAdd(&(bar)[XB_TMO], 1u); break; } } } } while (0)
struct XcdBarrier { unsigned* bar; unsigned x; volatile LAS unsigned* st; };
__device__ __forceinline__ XcdBarrier xcd_barrier_post(unsigned* bar, volatile LAS unsigned* st) {
    XcdBarrier b; b.bar = bar; b.x = xb_xcc_id(); b.st = st;
    if (threadIdx.x == 0) (void)xb_add(&bar[XB_XCNT(b.x)], 1u);
    return b;
}
__device__ __forceinline__ void xcd_barrier_complete(unsigned* bar, unsigned x, unsigned& nloc, unsigned& nx) {
    const unsigned G = gridDim.x * gridDim.y * gridDim.z;
    unsigned sum, cnt, mine, sp = 0u;
    for (;;) {
        sum = 0u; cnt = 0u; mine = 0u;
#pragma unroll
        for (unsigned j = 0; j < 16; ++j) { const unsigned c = xb_ld(&bar[XB_XCNT(j)]); sum += c; cnt += (c > 0u) ? 1u : 0u; mine = (j == x) ? c : mine; }
        if (sum == G) break;
        __builtin_amdgcn_s_sleep(1);
        if ((++sp & 255u) == 0u) { if (xb_ld(&bar[XB_TMO])) break; if (sp > XB_SPIN_CAP) { atomicAdd(&bar[XB_TMO], 1u); break; } }
    }
    nloc = mine > 0u ? mine : 1u; nx = cnt > 0u ? cnt : 1u;
}
__device__ __forceinline__ void xcd_barrier(const XcdBarrier& b) {
    asm volatile("s_waitcnt vmcnt(0)" ::: "memory");
    __syncthreads();
    if (threadIdx.x == 0) {
        unsigned* bar = b.bar;
        __builtin_amdgcn_s_waitcnt(0);
        unsigned nloc = b.st[0], nx = b.st[1];
        if (nloc == 0u) { xcd_barrier_complete(bar, b.x, nloc, nx); b.st[0] = nloc; b.st[1] = nx; }
        const unsigned old = xb_add(&bar[XB_XSUB(b.x)], 1u);
        const unsigned gen = old / nloc;
        if (old + 1u == (gen + 1u) * nloc) {
            __builtin_amdgcn_fence(__ATOMIC_RELEASE, "agent");
            asm volatile("s_waitcnt vmcnt(0)" ::: "memory");
            const unsigned og = xb_add(&bar[XB_TOP], 1u);
            const unsigned tg = og / nx;
            if (og + 1u == (tg + 1u) * nx) xb_add(&bar[XB_TOPGEN], 1u);
            else XB_SPIN(xb_ld(&bar[XB_TOPGEN]) == tg, bar);
            __builtin_amdgcn_fence(__ATOMIC_ACQUIRE, "agent");
            xb_add(&bar[XB_XGEN(b.x)], 1u);
            asm volatile("s_waitcnt vmcnt(0)" ::: "memory");
        } else {
            XB_SPIN(xb_ld(&bar[XB_XGEN(b.x)]) == gen, bar);
            __builtin_amdgcn_fence(__ATOMIC_ACQUIRE, "agent");
            asm volatile("s_waitcnt vmcnt(0)" ::: "memory");
        }
    }
    __syncthreads();
}

struct Args {
    const float* in[21]; float* out; unsigned char* ws; int ph_lo, ph_hi;
};
constexpr int NPHASE = 18;
#ifndef MK_EN
#define MK_EN 0xFFFF
#endif
#define EN(k) (((MK_EN) >> (k)) & 1)

__device__ __forceinline__ void transpose_item(const float* W, int N, int K, bf16_t* WT, int dst_row0, int k0, int n0, const float* kscale, LAS float* scr, int lane) {
#pragma unroll 8
    for (int i = 0; i < 32; ++i) { const int kk = 2 * i + (lane >> 5); float v = W[(size_t)(k0 + kk) * N + n0 + (lane & 31)]; if (kscale) v *= kscale[k0 + kk]; scr[kk * 33 + (lane & 31)] = v; }
    LDS_WAIT();
    const int c = lane & 7;
#pragma unroll
    for (int j = 0; j < 4; ++j) { const int n = (lane >> 3) + 8 * j; const LAS float* s = scr + (8 * c) * 33 + n;
        u32x4 o; o.x = cvt_pk_bf16(s[0 * 33], s[1 * 33]); o.y = cvt_pk_bf16(s[2 * 33], s[3 * 33]); o.z = cvt_pk_bf16(s[4 * 33], s[5 * 33]); o.w = cvt_pk_bf16(s[6 * 33], s[7 * 33]);
        *(u32x4*)(WT + (size_t)(dst_row0 + n) * K + k0 + 8 * c) = o; }
    LDS_WAIT();
}

template <bool DO_LN>
__device__ __forceinline__ void row_pass(const float* yrow, const float* lg, const float* lb, float* xout, bf16_t* xm, const float* sh, const float* sc, int lane, int nslab = 1) {
    f32x4 v[8];
#pragma unroll
    for (int j = 0; j < 8; ++j) v[j] = *(const f32x4*)(yrow + 4 * lane + 256 * j);
    for (int sl = 1; sl < nslab; ++sl) {
#pragma unroll
        for (int j = 0; j < 8; ++j) v[j] += *(const f32x4*)(yrow + (size_t)sl * NCTX * DM + 4 * lane + 256 * j);
    }
    if (DO_LN) {
        float s = 0.f;
#pragma unroll
        for (int j = 0; j < 8; ++j) s += (v[j][0] + v[j][1]) + (v[j][2] + v[j][3]);
        const float mean = wave_sum(s) * (1.0f / DM); float q = 0.f;
#pragma unroll
        for (int j = 0; j < 8; ++j) { v[j] = v[j] - mean; q += (v[j][0] * v[j][0] + v[j][1] * v[j][1]) + (v[j][2] * v[j][2] + v[j][3] * v[j][3]); }
        const float rstd = 1.0f / sqrtf(wave_sum(q) * (1.0f / DM) + LN_EPS);
#pragma unroll
        for (int j = 0; j < 8; ++j) { const f32x4 g = *(const f32x4*)(lg + 4 * lane + 256 * j), b = *(const f32x4*)(lb + 4 * lane + 256 * j); v[j] = v[j] * rstd * g + b; }
        if (xout) {
#pragma unroll
            for (int j = 0; j < 8; ++j) *(f32x4*)(xout + 4 * lane + 256 * j) = v[j];
        }
    }
    if (xm) {
#pragma unroll
        for (int j = 0; j < 8; ++j) { const f32x4 a = *(const f32x4*)(sc + 4 * lane + 256 * j), b = *(const f32x4*)(sh + 4 * lane + 256 * j); const f32x4 o = v[j] * (a + 1.0f) + b;
            u32x2 w; w.x = cvt_pk_bf16(o[0], o[1]); w.y = cvt_pk_bf16(o[2], o[3]); *(u32x2*)(xm + 4 * lane + 256 * j) = w; }
    }
}

typedef const __attribute__((address_space(4))) Args* KArgP;
__device__ __forceinline__ void run_phase(const int ph, LAS unsigned char* lds, const KArgP ap0, const int G, const int bx) {
        int tid = threadIdx.x; asm volatile("" : "+v"(tid));
        const int lane = tid & 63, wave = __builtin_amdgcn_readfirstlane(tid >> 6);
        KArgP ap = ap0; asm volatile("" : "+s"(ap));
        unsigned char* ws = ap->ws;
#define x_in (ap->in[0])
#define c_in (ap->in[1])
#define ctx_in (ap->in[2])
#define cctx_in (ap->in[3])
#define ada_w (ap->in[4])
#define ada_b (ap->in[5])
#define w_in (ap->in[6])
#define q_norm (ap->in[7])
#define wq_b (ap->in[8])
#define kv_norm (ap->in[9])
#define wkv_b (ap->in[10])
#define conv_w (ap->in[11])
#define na_rpb (ap->in[12])
#define w_out (ap->in[13])
#define ln1_g (ap->in[14])
#define ln1_b (ap->in[15])
#define w_gate (ap->in[16])
#define w_up (ap->in[17])
#define w_down (ap->in[18])
#define ln2_g (ap->in[19])
#define ln2_b (ap->in[20])
#define ctl ((unsigned*)(ws + WS_CTL))
#define SSQ ((float*)(ws + WS_SSQ))
#define MOD ((float*)(ws + WS_MOD))
#define XM ((bf16_t*)(ws + WS_XM))
#define Z ((bf16_t*)(ws + WS_Z))
#define QKV ((bf16_t*)(ws + WS_QKV))
#define HB ((bf16_t*)(ws + WS_H))
#define MIX ((bf16_t*)(ws + WS_MIX))
#define Y ((float*)(ws + WS_Y))
#define XMID ((float*)(ws + WS_XMID))
#define X1 ((float*)(ws + WS_X1))
#define YSLAB ((float*)(ws + WS_YS))
        if (ph == 0) { if (EN(0)) {
            for (int i = bx * 512 + tid; i < 8192; i += G * 512) ctl[i] = 0u;
            for (int i = bx * 512 + tid; i < 2 * MTOT * 2; i += G * 512) SSQ[i] = 0.f;
            {
                LAS float* sL = (LAS float*)lds; LAS float* red = (LAS float*)(lds + 40960);
                if (bx < 192) {
                    for (int i = tid; i < 5 * DM; i += 512) { const int b = i >> 11, k = i & (DM - 1); const float v = (b < 4) ? c_in[b * DM + k] : cctx_in[k]; sL[i] = v / (1.0f + __expf(-v)); }
                    __syncthreads();
                    for (int job = bx; job < 192; job += G) {
                        const int l = job / 96, col0 = (job % 96) * 128, c4 = tid & 31, ks = tid >> 5;
                        const float* Wp = ada_w + ((size_t)l * DM + ks * 128) * MODLD + col0 + c4 * 4;
                        f32x4 a0 = {0.f, 0.f, 0.f, 0.f}, a1 = a0, a2 = a0, a3 = a0, a4 = a0;
#pragma unroll 8
                        for (int k = 0; k < 128; ++k) { const f32x4 w = *(const f32x4*)(Wp + (size_t)k * MODLD); const int kk = ks * 128 + k;
                            a0 += w * sL[kk]; a1 += w * sL[DM + kk]; a2 += w * sL[2 * DM + kk]; a3 += w * sL[3 * DM + kk]; a4 += w * sL[4 * DM + kk]; }
                        *(LAS f32x4*)(red + (ks * 5 + 0) * 128 + c4 * 4) = a0; *(LAS f32x4*)(red + (ks * 5 + 1) * 128 + c4 * 4) = a1; *(LAS f32x4*)(red + (ks * 5 + 2) * 128 + c4 * 4) = a2;
                        *(LAS f32x4*)(red + (ks * 5 + 3) * 128 + c4 * 4) = a3; *(LAS f32x4*)(red + (ks * 5 + 4) * 128 + c4 * 4) = a4;
                        __syncthreads();
                        for (int i = tid; i < 640; i += 512) { const int b = i >> 7, cc = i & 127; float s = ada_b[(size_t)l * MODLD + col0 + cc];
#pragma unroll
                            for (int k2 = 0; k2 < 16; ++k2) s += red[(k2 * 5 + b) * 128 + cc];
                            MOD[((size_t)l * 5 + b) * MODLD + col0 + cc] = s; }
                        __syncthreads();
                    }
                }
                __syncthreads();
            }
            {
                LAS float* scr = (LAS float*)(lds + wave * 16384);
                const int gw = bx * 8 + wave, NGW = G * 8;
                constexpr int I_IN = 32 * 154, I_Q = 8 * 36, I_KV = 8 * 48, I_O = 32 * 64, I_G = 32 * 176, I_D = 88 * 64, I_LAYER = I_IN + I_Q + I_KV + I_O + 2 * I_G + I_D;
                for (int it = gw; it < 2 * I_LAYER; it += NGW) {
                    const int l = it / I_LAYER; int r = it % I_LAYER;
                    unsigned char* wl = ws + WS_W + (size_t)l * W_LAYER;
                    if (r < I_IN) { const int kb = r / 154, n0 = (r % 154) * 32; const int d0 = n0 < 1024 ? n0 : (n0 < 1088 ? n0 + 3840 : n0 - 64);
                        transpose_item(w_in + (size_t)l * DM * INDIM, INDIM, DM, (bf16_t*)(wl + W_IN), d0, kb * 64, n0, nullptr, scr, lane); continue; } r -= I_IN;
                    if (r < I_Q) { const int kb = r / 36, n0 = (r % 36) * 32; const int d0 = (n0 / 192) * 256 + (n0 % 192);
                        transpose_item(wq_b + (size_t)l * 512 * 1152, 1152, 512, (bf16_t*)(wl + W_QKV), d0, kb * 64, n0, q_norm + l * 512, scr, lane); continue; } r -= I_Q;
                    if (r < I_KV) { const int kb = r / 48, n0 = (r % 48) * 32;
                        transpose_item(wkv_b + (size_t)l * 512 * 1536, 1536, 512, (bf16_t*)(wl + W_QKV), 1536 + n0, kb * 64, n0, kv_norm + l * 512, scr, lane); continue; } r -= I_KV;
                    if (r < I_O) { const int kb = r / 64, n0 = (r % 64) * 32;
                        transpose_item(w_out + (size_t)l * DM * DM, DM, DM, (bf16_t*)(wl + W_O), n0, kb * 64, n0, nullptr, scr, lane); continue; } r -= I_O;
                    if (r < I_G) { const int kb = r / 176, n0 = (r % 176) * 32; const int d0 = (n0 / 128) * 256 + (n0 % 128);
                        transpose_item(w_gate + (size_t)l * DM * FF, FF, DM, (bf16_t*)(wl + W_GU), d0, kb * 64, n0, nullptr, scr, lane); continue; } r -= I_G;
                    if (r < I_G) { const int kb = r / 176, n0 = (r % 176) * 32; const int d0 = (n0 / 128) * 256 + 128 + (n0 % 128);
                        transpose_item(w_up + (size_t)l * DM * FF, FF, DM, (bf16_t*)(wl + W_GU), d0, kb * 64, n0, nullptr, scr, lane); continue; } r -= I_G;
                    { const int kb = r / 64, n0 = (r % 64) * 32;
                        transpose_item(w_down + (size_t)l * FF * DM, DM, FF, (bf16_t*)(wl + W_D), n0, kb * 64, n0, nullptr, scr, lane); }
                }
                const u32x4 z4 = {0u, 0u, 0u, 0u};
                for (int i = bx * 512 + tid; i < 2 * (192 * 256 + 384 * 64); i += G * 512) {
                    const int l = i / (192 * 256 + 384 * 64); int r = i % (192 * 256 + 384 * 64); unsigned char* wl = ws + WS_W + (size_t)l * W_LAYER;
                    if (r < 192 * 256) { *(u32x4*)((bf16_t*)(wl + W_IN) + (size_t)(4928 + r / 256) * DM + (r % 256) * 8) = z4; }
                    else { r -= 192 * 256; const int rr = r / 64, h = rr / 64, j = rr % 64; *(u32x4*)((bf16_t*)(wl + W_QKV) + (size_t)(h * 256 + 192 + j) * 512 + (r % 64) * 8) = z4; }
                }
            }
        } } else if (ph == 1) { if (EN(1))
            for (int row = bx * 8 + wave; row < MTOT; row += G * 8) {
                const int bidx = row < NLAT ? (row >> 11) : 4; const float* src = row < NLAT ? x_in + (size_t)row * DM : ctx_in + (size_t)(row - NLAT) * DM;
                const float* mod = MOD + (size_t)bidx * MODLD;
                row_pass<false>(src, nullptr, nullptr, nullptr, XM + (size_t)row * DM, mod, mod + DM, lane);
            }
        } else {
            const int l = (ph - 2) >> 3, sub = (ph - 2) & 7; const bool last = (l == 1);
            unsigned char* wl = ws + WS_W + (size_t)l * W_LAYER;
            float* ssq = SSQ + (size_t)l * MTOT * 2;
            const float* modl = MOD + (size_t)l * 5 * MODLD;
            const int nMpost = last ? 32 : 36;
            if (sub == 0) { if (EN(2)) {
                pg8::Gemm g{XM, (const bf16_t*)(wl + W_IN), DM, DM, DM, 1 << 30, 0}; pg8::StaticOrder S; S.init(36, 20, G, bx, DM / 64);
                EpiZ E{Z, ssq}; pg8::gemm_phase(lds, g, S, E, tid);
            } } else if (sub == 1) { if (EN(3)) {
                pg8::Gemm g{Z + ZC_Q, (const bf16_t*)(wl + W_QKV), ZLD, 512, 512, 6, 512 * 2}; pg8::StaticOrder S; S.init(36, 12, G, bx, 512 / 64);
                EpiQKV E{QKV, ssq}; pg8::gemm_phase(lds, g, S, E, tid);
            } } else if (sub == 2) { if (EN(4)) {
                unsigned* ctr = ctl + 64 * (1 + l);
                const int nctxq = last ? 0 : 24, nconv = last ? 128 : 144;
                const int J_NA = 192, J_MC = 384, J_NC = J_MC + nctxq, J_CV = J_NC + nctxq, J_END = J_CV + nconv;
                LAS int* jobslot = (LAS int*)(lds + JOB_OFF);
                for (;;) {
                    __syncthreads();
                    if (tid == 0) *jobslot = (int)atomicAdd(ctr, 1u);
                    __syncthreads();
                    const int job = __builtin_amdgcn_readfirstlane(*jobslot);
                    if (job >= J_END) break;
                    int tj = tid; asm volatile("" : "+v"(tj));
                    AttnJob J; J.R0 = 0; J.krow_lo = 0; J.rpb = nullptr; J.ldo = DM;
                    if (job < J_NA) {
                        const int b = job / 48, h = (job / 8) % 6, qb = job % 8;
                        J.Q = QKV + h * 256; J.ldq = QLD; J.Kn = QKV + 1536 + h * 256; J.ldk = QLD; J.Kr = Z + ZC_KR; J.ldkr = ZLD; J.V = QKV + 1536 + h * 256 + 128; J.ldv = QLD;
                        J.O = MIX + h * 128; J.q0 = b * SEQ + qb * 256; J.ctx_base = NLAT + b * CTXL; J.nctx_tiles = 4; J.lat_base = b * SEQ; J.nlat_tiles = 32;
                        if (EN(10)) attn_unit<192, false>(lds, J, tj);
                    } else if (job < J_MC) {
                        const int j = job - J_NA, b = j / 48, h = (j / 8) % 6, rb = j % 8, R0 = 4 * rb;
                        const int klo = min(max(R0 - 4, 0), 24), khi = min(max(R0 - 1, 0), 24) + 7;
                        J.Q = Z + ZC_NQ + h * 128; J.ldq = ZLD; J.Kn = Z + ZC_NK + h * 128; J.ldk = ZLD; J.Kr = nullptr; J.ldkr = 0; J.V = Z + ZC_NV + h * 128; J.ldv = ZLD;
                        J.O = MIX + 1280 + h * 128; J.q0 = b * SEQ + 256 * rb; J.ctx_base = NLAT + b * CTXL; J.nctx_tiles = 4; J.lat_base = b * SEQ + 64 * klo; J.nlat_tiles = khi - klo + 1;
                        J.R0 = R0; J.krow_lo = klo; J.rpb = na_rpb + ((size_t)l * 6 + h) * 15 * 31;
                        if (EN(11)) attn_unit<128, true>(lds, J, tj);
                    } else if (job < J_NC) {
                        const int j = job - J_MC, b = j / 6, h = j % 6;
                        J.Q = QKV + h * 256; J.ldq = QLD; J.Kn = QKV + 1536 + h * 256; J.ldk = QLD; J.Kr = Z + ZC_KR; J.ldkr = ZLD; J.V = QKV + 1536 + h * 256 + 128; J.ldv = QLD;
                        J.O = MIX + h * 128; J.q0 = NLAT + b * CTXL; J.ctx_base = NLAT + b * CTXL; J.nctx_tiles = 4; J.lat_base = 0; J.nlat_tiles = 0;
                        if (EN(10)) attn_unit<192, false>(lds, J, tj);
                    } else if (job < J_CV) {
                        const int j = job - J_NC, b = j / 6, h = j % 6;
                        J.Q = Z + ZC_NQ + h * 128; J.ldq = ZLD; J.Kn = Z + ZC_NK + h * 128; J.ldk = ZLD; J.Kr = nullptr; J.ldkr = 0; J.V = Z + ZC_NV + h * 128; J.ldv = ZLD;
                        J.O = MIX + 1280 + h * 128; J.q0 = NLAT + b * CTXL; J.ctx_base = NLAT + b * CTXL; J.nctx_tiles = 4; J.lat_base = 0; J.nlat_tiles = 0;
                        if (EN(12)) attn_unit<128, false>(lds, J, tj);
                    } else {
                        const int cj = job - J_CV; const float* cw = conv_w + (size_t)l * 3 * 512;
                        for (int it = tj; it < 64 * 64; it += 512) {
                            const int row = cj * 64 + (it >> 6), ch = (it & 63) * 8;
                            const int pos = row < NLAT ? (row & (SEQ - 1)) : ((row - NLAT) & (CTXL - 1)), len = row < NLAT ? SEQ : CTXL;
                            const bf16_t* zr = Z + (size_t)row * ZLD;
                            const u32x4 zz = {0u, 0u, 0u, 0u};
                            const u32x4 gb = *(const u32x4*)(zr + ZC_CB + ch);
                            const u32x4 c1 = *(const u32x4*)(zr + ZC_CC + ch), h1 = *(const u32x4*)(zr + ZC_CH + ch);
                            const u32x4 c0v = pos > 0 ? *(const u32x4*)(zr - ZLD + ZC_CC + ch) : zz, h0v = pos > 0 ? *(const u32x4*)(zr - ZLD + ZC_CH + ch) : zz;
                            const u32x4 c2 = pos < len - 1 ? *(const u32x4*)(zr + ZLD + ZC_CC + ch) : zz, h2 = pos < len - 1 ? *(const u32x4*)(zr + ZLD + ZC_CH + ch) : zz;
                            const f32x4 w0a = *(const f32x4*)(cw + ch), w0b = *(const f32x4*)(cw + ch + 4), w1a = *(const f32x4*)(cw + 512 + ch), w1b = *(const f32x4*)(cw + 512 + ch + 4);
                            const f32x4 w2a = *(const f32x4*)(cw + 1024 + ch), w2b = *(const f32x4*)(cw + 1024 + ch + 4);
                            u32x4 o;
#pragma unroll
                            for (int e = 0; e < 4; ++e) {
                                const float wl0 = e < 2 ? w0a[2 * e] : w0b[2 * e - 4], wh0 = e < 2 ? w0a[2 * e + 1] : w0b[2 * e - 3];
                                const float wl1 = e < 2 ? w1a[2 * e] : w1b[2 * e - 4], wh1 = e < 2 ? w1a[2 * e + 1] : w1b[2 * e - 3];
                                const float wl2 = e < 2 ? w2a[2 * e] : w2b[2 * e - 4], wh2 = e < 2 ? w2a[2 * e + 1] : w2b[2 * e - 3];
                                const float ylo = bflo(c0v[e]) * bflo(h0v[e]) * wl0 + bflo(c1[e]) * bflo(h1[e]) * wl1 + bflo(c2[e]) * bflo(h2[e]) * wl2;
                                const float yhi = bfhi(c0v[e]) * bfhi(h0v[e]) * wh0 + bfhi(c1[e]) * bfhi(h1[e]) * wh1 + bfhi(c2[e]) * bfhi(h2[e]) * wh2;
                                o[e] = cvt_pk_bf16(bflo(gb[e]) * ylo, bfhi(gb[e]) * yhi);
                            }
                            *(u32x4*)(MIX + (size_t)row * DM + 768 + ch) = o;
                        }
                    }
                }
            } } else if (sub == 3) { if (EN(5)) {
                pg8::Gemm g{MIX, (const bf16_t*)(wl + W_O), DM, DM, DM, 1 << 30, 0};
                if (!last) { pg8::SplitOrder S; S.init(8, G, bx, DM / 64, 4, 4); EpiRes E{x_in, ctx_in - (size_t)NLAT * DM, modl + 2 * DM, Y, YSLAB}; pg8::gemm_phase(lds, g, S, E, tid); }
                else { pg8::StaticOrder S; S.init(32, 8, G, bx, DM / 64); EpiRes E{X1, X1, modl + 2 * DM, Y, nullptr}; pg8::gemm_phase(lds, g, S, E, tid); }
            } } else if (sub == 4) { if (EN(6)) {
                for (int row = bx * 8 + wave; row < nMpost * 256; row += G * 8) {
                    const int bidx = row < NLAT ? (row >> 11) : 4; const float* mod = modl + (size_t)bidx * MODLD;
                    const bool slab = row >= NLAT;
                    row_pass<true>(slab ? YSLAB + (size_t)(row - NLAT) * DM : Y + (size_t)row * DM, ln1_g + l * DM, ln1_b + l * DM, XMID + (size_t)row * DM, XM + (size_t)row * DM, mod + 3 * DM, mod + 4 * DM, lane, slab ? 8 : 1);
                }
            } } else if (sub == 5) { if (EN(7)) {
                pg8::Gemm g{XM, (const bf16_t*)(wl + W_GU), DM, DM, DM, 1 << 30, 0}; pg8::StaticOrder S; S.init(nMpost, 44, G, bx, DM / 64);
                EpiSwiGLU E{HB}; pg8::gemm_phase(lds, g, S, E, tid);
            } } else if (sub == 6) { if (EN(8)) {
                pg8::Gemm g{HB, (const bf16_t*)(wl + W_D), FF, FF, FF, 1 << 30, 0}; EpiRes E{XMID, XMID, modl + 5 * DM, Y, last ? nullptr : YSLAB};
                if (!last) { pg8::SplitOrder S; S.init(8, G, bx, FF / 64, 12, 10); pg8::gemm_phase(lds, g, S, E, tid); }
                else { pg8::StaticOrder S; S.init(32, 8, G, bx, FF / 64); pg8::gemm_phase(lds, g, S, E, tid); }
            } } else { if (EN(9)) {
                for (int row = bx * 8 + wave; row < nMpost * 256; row += G * 8) {
                    const int bidx = row < NLAT ? (row >> 11) : 4;
                    if (!last) { const float* mod = MOD + (size_t)(5 + bidx) * MODLD; const bool slab = row >= NLAT;
                        row_pass<true>(slab ? YSLAB + (size_t)(row - NLAT) * DM : Y + (size_t)row * DM, ln2_g + l * DM, ln2_b + l * DM, X1 + (size_t)row * DM, XM + (size_t)row * DM, mod, mod + DM, lane, slab ? 8 : 1); }
                    else row_pass<true>(Y + (size_t)row * DM, ln2_g + l * DM, ln2_b + l * DM, ap->out + (size_t)row * DM, nullptr, nullptr, nullptr, lane);
                }
            } }
        }
}
__global__ void __launch_bounds__(512, 2) mega_fwd(Args args) {
    extern __shared__ __attribute__((aligned(16))) unsigned char lds_raw[];
    LAS unsigned char* lds = (LAS unsigned char*)lds_raw;
    cg::grid_group grid = cg::this_grid();
    const int G = gridDim.x, bx = blockIdx.x;
    const KArgP ap0 = (KArgP)__builtin_amdgcn_kernarg_segment_ptr();
    const int lo = ap0->ph_lo, hi_ph = ap0->ph_hi;
    volatile LAS unsigned* bst = (volatile LAS unsigned*)(lds + JOB_OFF + 64);
    if (threadIdx.x == 0) { bst[0] = 0u; bst[1] = 0u; }
    __syncthreads();
    XcdBarrier xb; xb.bar = (unsigned*)(ap0->ws + WS_CTL) + 4096; xb.x = 0; xb.st = bst;
#define RUN(k) if (lo <= (k) && (k) < hi_ph) { run_phase((k), lds, ap0, G, bx); if ((k) + 1 < hi_ph) { if ((k) == lo) { grid.sync(); xb = xcd_barrier_post(xb.bar, bst); } else xcd_barrier(xb); } }
    RUN(0) RUN(1) RUN(2) RUN(3) RUN(4) RUN(5) RUN(6) RUN(7) RUN(8) RUN(9) RUN(10) RUN(11) RUN(12) RUN(13) RUN(14) RUN(15) RUN(16) RUN(17)
#undef RUN
}

#ifndef MK_PER_PHASE
#define MK_PER_PHASE 0
#endif
extern "C" void kernel_launch(void* const* d_in, const int* in_sizes, int n_in, void* d_out, int out_size, void* d_ws, size_t ws_size, hipStream_t stream) {
    static int grid = 0;
    if (grid == 0) {
        if (n_in != 21 || ws_size < WS_END) { fprintf(stderr, "kernel_launch: expected 21 inputs and >= %zu bytes of workspace; got %d, %zu\n", (size_t)WS_END, n_in, ws_size); grid = -1; return; }
        int dev = 0, cus = 0, per_cu = 0;
        (void)hipGetDevice(&dev); (void)hipDeviceGetAttribute(&cus, hipDeviceAttributeMultiprocessorCount, dev);
        if (hipFuncSetAttribute((const void*)mega_fwd, hipFuncAttributeMaxDynamicSharedMemorySize, LDS_BYTES) != hipSuccess) { fprintf(stderr, "kernel_launch: hipFuncSetAttribute failed\n"); grid = -1; return; }
        if (hipOccupancyMaxActiveBlocksPerMultiprocessor(&per_cu, (const void*)mega_fwd, 512, LDS_BYTES) != hipSuccess || per_cu < 1) { fprintf(stderr, "kernel_launch: occupancy query says %d blocks per CU\n", per_cu); per_cu = 1; }
        (void)hipGetLastError();
        grid = cus;
        if (grid > cus * per_cu) grid = cus * per_cu;
    }
    if (grid < 0) return;
    Args a{};
    for (int i = 0; i < 21; ++i) a.in[i] = (const float*)d_in[i];
    a.out = (float*)d_out; a.ws = (unsigned char*)d_ws;
#if MK_PER_PHASE
    for (int ph = 0; ph < NPHASE; ++ph) { a.ph_lo = ph; a.ph_hi = ph + 1; void* kargs[] = {&a};
        hipError_t e = hipLaunchCooperativeKernel((const void*)mega_fwd, dim3(grid), dim3(512), kargs, LDS_BYTES, stream);
        if (e != hipSuccess) { fprintf(stderr, "launch %d failed: %s\n", ph, hipGetErrorString(e)); break; } }
#else
    a.ph_lo = 0; a.ph_hi = NPHASE; void* kargs[] = {&a};
    hipError_t e = hipLaunchCooperativeKernel((const void*)mega_fwd, dim3(grid), dim3(512), kargs, LDS_BYTES, stream);
    if (e != hipSuccess) fprintf(stderr, "cooperative launch failed: %s (grid %d)\n", hipGetErrorString(e), grid);
#endif
}
```

```cpp
#include <hip/hip_runtime.h>
#include <hip/hip_cooperative_groups.h>
#include <cstdio>
#include <cstdint>
namespace cg = cooperative_groups;

#define LAS __attribute__((address_space(3)))
typedef unsigned short bf16_t;
typedef short bf16x8 __attribute__((ext_vector_type(8)));
typedef short s16x4 __attribute__((ext_vector_type(4)));
typedef float f32x4 __attribute__((ext_vector_type(4)));
typedef float f32x16 __attribute__((ext_vector_type(16)));
typedef unsigned u32x4 __attribute__((ext_vector_type(4)));
typedef unsigned u32x2 __attribute__((ext_vector_type(2)));

constexpr int DM = 2048, NBATCH = 4, SEQ = 2048, CTXL = 256, NLAT = NBATCH * SEQ, NCTX = NBATCH * CTXL, MTOT = NLAT + NCTX;
constexpr int INDIM = 4928, ZLD = 5120, QLD = 3072, FF = 5632, MODLD = 6 * DM;
constexpr int ZC_Q = 0, ZC_KV = 512, ZC_CB = 1024, ZC_CC = 1536, ZC_CH = 2048, ZC_NQ = 2560, ZC_NK = 3328, ZC_NV = 4096, ZC_KR = 4864;
constexpr float LOG2E = 1.4426950408889634f;
constexpr float QS_MLA = 0.07216878364870323f * LOG2E;
constexpr float QS_NA = 0.08838834764831845f * LOG2E;
constexpr float DN_ALPHA = 1.4142135623730951f;
constexpr float LN_EPS = 1e-6f, RMS_EPS = 1e-6f;

constexpr size_t MiB = 1u << 20;
constexpr size_t WS_CTL = 0;
constexpr size_t WS_SSQ = 1 * MiB;
constexpr size_t WS_MOD = 2 * MiB;
constexpr size_t WS_W = 3 * MiB;
constexpr size_t W_IN = 0, W_QKV = 20 * MiB, W_O = 23 * MiB, W_GU = 31 * MiB, W_D = 75 * MiB, W_LAYER = 97 * MiB;
constexpr size_t WS_XM = WS_W + 2 * W_LAYER;
constexpr size_t WS_Z = WS_XM + 36 * MiB;
constexpr size_t WS_QKV = WS_Z + 90 * MiB;
constexpr size_t WS_H = WS_Z;
constexpr size_t WS_MIX = WS_QKV + 54 * MiB;
constexpr size_t WS_Y = WS_MIX + 36 * MiB;
constexpr size_t WS_XMID = WS_Y + 72 * MiB;
constexpr size_t WS_X1 = WS_XMID + 72 * MiB;
constexpr size_t WS_YS = WS_X1 + 72 * MiB;
constexpr size_t WS_KM = WS_YS + 64 * MiB;
constexpr size_t WS_VM = WS_KM + 21 * MiB;
constexpr size_t WS_NKM = WS_VM + 14 * MiB;
constexpr size_t WS_NVM = WS_NKM + 14 * MiB;
constexpr size_t WS_END = WS_NVM + 14 * MiB;
static_assert(WS_END <= 768 * MiB, "d_ws map");

constexpr int LDS_BYTES = 147456;
constexpr int JOB_OFF = 140 * 1024;

__device__ __forceinline__ unsigned cvt_pk_bf16(float lo, float hi) {
    typedef float f32x2_t __attribute__((ext_vector_type(2))); typedef __bf16 bf16x2_t __attribute__((ext_vector_type(2)));
    f32x2_t v = {lo, hi}; bf16x2_t b = __builtin_convertvector(v, bf16x2_t); return __builtin_bit_cast(unsigned, b);
}
__device__ __forceinline__ float bflo(unsigned w) { return __uint_as_float(w << 16); }
__device__ __forceinline__ float bfhi(unsigned w) { return __uint_as_float(w & 0xffff0000u); }
__device__ __forceinline__ u32x4 pack8(const f32x4 a, const f32x4 b) { u32x4 w; w.x = cvt_pk_bf16(a[0], a[1]); w.y = cvt_pk_bf16(a[2], a[3]); w.z = cvt_pk_bf16(b[0], b[1]); w.w = cvt_pk_bf16(b[2], b[3]); return w; }
__device__ __forceinline__ float wave_sum(float v) {
#pragma unroll
    for (int o = 1; o < 64; o <<= 1) v += __shfl_xor(v, o);
    return v;
}
#define LDS_WAIT() asm volatile("s_waitcnt lgkmcnt(0)" ::: "memory")

__device__ __forceinline__ void rope8(f32x4& v0, f32x4& v1, int fq, float pos) {
    const float sgn = (fq < 2) ? -1.f : 1.f;
    const int ib = 8 * (fq & 1);
#pragma unroll
    for (int e = 0; e < 4; ++e) {
        const float p0 = __shfl_xor(v0[e], 32), p1 = __shfl_xor(v1[e], 32);
        const float a0 = pos * __builtin_amdgcn_exp2f(-(float)(ib + e) * 0.8304820237218406f);
        const float a1 = pos * __builtin_amdgcn_exp2f(-(float)(ib + 4 + e) * 0.8304820237218406f);
        const float c0 = __cosf(a0), s0 = __sinf(a0), c1 = __cosf(a1), s1 = __sinf(a1);
        v0[e] = v0[e] * c0 + sgn * p0 * s0; v1[e] = v1[e] * c1 + sgn * p1 * s1;
    }
}

namespace pg8 {
constexpr int BM = 256, BK = 64, HALF = 128, HTB = HALF * BK * 2, STAGE_BYTES = 8 * HTB, NXCD = 8, WGM = 8;
__host__ __device__ __forceinline__ int lds_byte(int r, int c) { const int st = (r >> 4) * 2 + (c >> 5), rr = r & 15, cc = c & 31, ob = rr * 64 + cc * 2; return st * 1024 + (ob ^ (((ob >> 9) & 1) << 5)); }
__host__ __device__ __forceinline__ void stage_rc(int b, int& R, int& C) { const int st = b / 1024, sb = b % 1024, swz = sb ^ (((sb >> 9) & 1) << 5); R = (st >> 1) * 16 + swz / 64; C = (st & 1) * 32 + (swz % 64) / 2; }
__host__ __device__ __forceinline__ int perm32(int rho) { const int n = rho >> 4, i = rho & 15; return 8 * (i >> 2) + 4 * n + (i & 3); }
struct Unit { int pm, pn, kt0, nkt, ks; };
struct Gemm { const bf16_t* A; const bf16_t* Bt; int lda, ldb, K; int split_pn, split_off; };
struct StaticOrder {
    int nM, nN, nwg, G, c, nkt;
    __device__ void init(int nM_, int nN_, int G_, int c_, int nkt_) { nM = nM_; nN = nN_; nwg = nM * nN; G = G_; c = c_; nkt = nkt_; }
    __device__ bool map(long L, Unit& u) const {
        if (L >= nwg) return false; u.kt0 = 0; u.nkt = nkt; u.ks = 0;
        int wgid = (int)L; { const int q = nwg / NXCD, r = nwg % NXCD, xcd = wgid % NXCD, off = wgid / NXCD; wgid = (xcd < r ? xcd * (q + 1) : r * (q + 1) + (xcd - r) * q) + off; }
        const int nig = WGM * nN, gid = wgid / nig, fm = gid * WGM, gsz = (nM - fm) < WGM ? (nM - fm) : WGM;
        u.pm = fm + ((wgid % nig) % gsz); u.pn = (wgid % nig) / gsz; return true;
    }
    __device__ bool next(int i, Unit& u) const { return map((long)i * G + c, u); }
};
struct SplitOrder {
    StaticOrder lat; int nN, nk_even, nk_odd;
    __device__ void init(int nN_, int G_, int c_, int nkt_, int nk_even_, int nk_odd_) { lat.init(32, nN_, G_, c_, nkt_); nN = nN_; nk_even = nk_even_; nk_odd = nk_odd_; }
    __device__ bool next(int i, Unit& u) const {
        const long L = (long)i * lat.G + lat.c; const bool isl = L < lat.nwg;
        Unit a; (void)lat.map(isl ? L : 0, a);
        const int j = isl ? 0 : (int)(L - lat.nwg);
        const int sub = j & 7, cu = j >> 3;
        u.pn = isl ? a.pn : cu % nN; u.pm = isl ? a.pm : 32 + cu / nN; u.ks = isl ? 0 : sub;
        u.kt0 = isl ? 0 : (sub >> 1) * (nk_even + nk_odd) + (sub & 1) * nk_even; u.nkt = isl ? a.nkt : ((sub & 1) ? nk_odd : nk_even);
        return isl || j < 4 * nN * 8;
    }
};
template <class Epi, class Sched>
__device__ __forceinline__ void gemm_phase(LAS unsigned char* lds, const Gemm g, const Sched& S, const Epi& E, const int tid) {
    const int wid = __builtin_amdgcn_readfirstlane(tid >> 6), lane = tid & 63, wr = wid >> 2, wc = wid & 3, fr = lane & 15, fq = lane >> 4;
    unsigned voffA[2], voffB[2];
#pragma unroll
    for (int i = 0; i < 2; ++i) { int R, C; stage_rc(tid * 16 + i * 8192, R, C); const int Rb = (R & ~31) + perm32(R & 31);
        voffA[i] = (unsigned)(R * g.lda + C) * 2u; voffB[i] = (unsigned)(Rb * g.ldb + C) * 2u; }
    const size_t kstep = (size_t)(BK * 2);
    const size_t hstepA = (size_t)HALF * g.lda * 2, hstepB = (size_t)HALF * g.ldb * 2;
    const size_t tstepA = 2 * hstepA, tstepB = 2 * hstepB;
    const unsigned ldsw = (unsigned)wid * 1024u;
    const int aoff = lds_byte(wr * 64 + fr, fq * 8), boff = lds_byte(wc * 32 + fr, fq * 8);
#define PG8_SA(b, h) (((b) * 2 + (h)) * HTB)
#define PG8_SB(b, h) ((4 + (b) * 2 + (h)) * HTB)
#define PG8_STAGE(bufoff, gbase, voff) do { _Pragma("unroll") for (int _i = 0; _i < 2; ++_i) \
        __builtin_amdgcn_global_load_lds((const unsigned*)((const char*)(gbase) + (voff)[_i]), (LAS unsigned*)(lds + (bufoff) + ldsw + _i * 8192), 16, 0, 0); } while (0)
#define PG8_LDA(dst, b, h) do { _Pragma("unroll") for (int m = 0; m < 4; ++m) _Pragma("unroll") for (int k = 0; k < 2; ++k) dst[m][k] = *(const LAS bf16x8*)(lds + PG8_SA(b, h) + aoff + m * 2048 + k * 1024); } while (0)
#define PG8_LDB(dst, b, h) do { _Pragma("unroll") for (int n = 0; n < 2; ++n) _Pragma("unroll") for (int k = 0; k < 2; ++k) dst[n][k] = *(const LAS bf16x8*)(lds + PG8_SB(b, h) + boff + n * 2048 + k * 1024); } while (0)
#define PG8_MMA(ai, bj, At, Bt) do { __builtin_amdgcn_s_setprio(1); _Pragma("unroll") for (int m = 0; m < 4; ++m) _Pragma("unroll") for (int n = 0; n < 2; ++n) _Pragma("unroll") for (int k = 0; k < 2; ++k) \
        acc[ai][bj][m][n] = __builtin_amdgcn_mfma_f32_16x16x32_bf16(Bt[n][k], At[m][k], acc[ai][bj][m][n], 0, 0, 0); __builtin_amdgcn_s_setprio(0); } while (0)
#define PG8_WAIT_V(n) asm volatile("s_waitcnt vmcnt(" #n ")" ::: "memory")
#define PG8_WAIT_L(n) asm volatile("s_waitcnt lgkmcnt(" #n ")" ::: "memory")
#define PG8_BAR __builtin_amdgcn_s_barrier()
#define PG8_SCHED __builtin_amdgcn_sched_barrier(0)
    Unit cur, nxt; int ui = 0;
    if (!S.next(0, cur)) return;
    f32x4 acc[2][2][4][2];
#pragma unroll
    for (int a = 0; a < 2; ++a)
#pragma unroll
        for (int b = 0; b < 2; ++b)
#pragma unroll
            for (int m = 0; m < 4; ++m)
#pragma unroll
                for (int n = 0; n < 2; ++n) acc[a][b][m][n] = (f32x4){0.f, 0.f, 0.f, 0.f};
    bf16x8 At[4][2], B0[2][2], B1[2][2];
    const char* cA = (const char*)g.A + (size_t)cur.pm * tstepA + (cur.pn >= g.split_pn ? g.split_off : 0) + (size_t)cur.kt0 * kstep; const char* cB = (const char*)g.Bt + (size_t)cur.pn * tstepB + (size_t)cur.kt0 * kstep;
    PG8_STAGE(PG8_SB(0, 0), cB, voffB); PG8_STAGE(PG8_SB(0, 1), cB + hstepB, voffB); PG8_STAGE(PG8_SA(0, 0), cA, voffA); PG8_STAGE(PG8_SA(0, 1), cA + hstepA, voffA);
    if (wr == 1) PG8_BAR;
    PG8_WAIT_V(2); PG8_BAR;
    PG8_STAGE(PG8_SB(1, 0), cB + kstep, voffB); PG8_STAGE(PG8_SA(1, 0), cA + kstep, voffA); PG8_STAGE(PG8_SB(1, 1), cB + hstepB + kstep, voffB);
    PG8_WAIT_V(6); PG8_BAR;
    for (;;) {
        const bool has_next = S.next(ui + 1, nxt);
        const char* nA = has_next ? (const char*)g.A + (size_t)nxt.pm * tstepA + (nxt.pn >= g.split_pn ? g.split_off : 0) + (size_t)nxt.kt0 * kstep : cA; const char* nB = has_next ? (const char*)g.Bt + (size_t)nxt.pn * tstepB + (size_t)nxt.kt0 * kstep : cB;
        const int nt = cur.nkt;
        for (int t = 0; t < nt; t += 2) {
            const bool last = (t == nt - 2);
            const char* a1 = cA + (size_t)(t + 1) * kstep;
            const char* a2 = last ? nA : cA + (size_t)(t + 2) * kstep; const char* b2 = last ? nB : cB + (size_t)(t + 2) * kstep;
            const char* a3 = a2 + kstep; const char* b3 = b2 + kstep;
            PG8_LDB(B0, 0, 0); PG8_LDB(B1, 0, 1); PG8_SCHED; PG8_LDA(At, 0, 0); PG8_STAGE(PG8_SA(1, 1), a1 + hstepA, voffA);
            PG8_WAIT_V(8); PG8_WAIT_L(0); PG8_BAR; PG8_MMA(0, 0, At, B0); PG8_MMA(0, 1, At, B1); PG8_BAR; PG8_SCHED;
            PG8_LDA(At, 0, 1); PG8_STAGE(PG8_SB(0, 0), b2, voffB); PG8_STAGE(PG8_SB(0, 1), b2 + hstepB, voffB); PG8_STAGE(PG8_SA(0, 0), a2, voffA);
            PG8_WAIT_V(8); PG8_WAIT_L(0); PG8_BAR; PG8_MMA(1, 0, At, B0); PG8_MMA(1, 1, At, B1); PG8_BAR; PG8_SCHED;
            PG8_LDB(B0, 1, 0); PG8_LDB(B1, 1, 1); PG8_SCHED; PG8_LDA(At, 1, 0); PG8_STAGE(PG8_SA(0, 1), a2 + hstepA, voffA);
            PG8_WAIT_V(8); PG8_WAIT_L(0); PG8_BAR; PG8_MMA(0, 0, At, B0); PG8_MMA(0, 1, At, B1); PG8_BAR; PG8_SCHED;
            PG8_LDA(At, 1, 1); PG8_STAGE(PG8_SB(1, 0), b3, voffB); PG8_STAGE(PG8_SB(1, 1), b3 + hstepB, voffB); PG8_STAGE(PG8_SA(1, 0), a3, voffA);
            PG8_WAIT_V(8); PG8_WAIT_L(0); PG8_BAR; PG8_MMA(1, 0, At, B0); PG8_MMA(1, 1, At, B1); PG8_BAR; PG8_SCHED;
        }
        if (wr == 0) PG8_BAR;
        E(acc, cur, wr, wc, fr, fq);
        if (!has_next) break;
#pragma unroll
        for (int a = 0; a < 2; ++a)
#pragma unroll
            for (int b = 0; b < 2; ++b)
#pragma unroll
                for (int m = 0; m < 4; ++m)
#pragma unroll
                    for (int n = 0; n < 2; ++n) acc[a][b][m][n] = (f32x4){0.f, 0.f, 0.f, 0.f};
        cur = nxt; cA = nA; cB = nB; ++ui;
        if (wr == 1) PG8_BAR;
    }
    PG8_WAIT_V(0);
    PG8_BAR;
#undef PG8_SA
#undef PG8_SB
#undef PG8_STAGE
#undef PG8_LDA
#undef PG8_LDB
#undef PG8_MMA
#undef PG8_WAIT_V
#undef PG8_WAIT_L
#undef PG8_BAR
#undef PG8_SCHED
}
}
using pg8::Unit;
typedef f32x4 AccT[2][2][4][2];

constexpr int NKEY = CTXL + SEQ;
__device__ __forceinline__ int key_slot(int row) { return row < NLAT ? (row >> 11) * 6 * NKEY + CTXL + (row & (SEQ - 1)) : ((row - NLAT) >> 8) * 6 * NKEY + ((row - NLAT) & (CTXL - 1)); }
struct EpiZ {
    bf16_t* Zp; float* ssq; bf16_t* KM; bf16_t* NKM; bf16_t* NVM;
    __device__ __forceinline__ void operator()(const AccT& acc, const Unit& u, int wr, int wc, int fr, int fq) const {
        const int pn = u.pn, colb = pn * 256 + wc * 32 + 8 * fq;
#pragma unroll
        for (int ai = 0; ai < 2; ++ai)
#pragma unroll
            for (int m = 0; m < 4; ++m) {
                const int row = u.pm * 256 + ai * 128 + wr * 64 + m * 16 + fr;
                f32x4 a0 = acc[ai][0][m][0], a1 = acc[ai][0][m][1], b0 = acc[ai][1][m][0], b1 = acc[ai][1][m][1];
                if (pn < 4) {
                    f32x4 q = a0 * a0 + a1 * a1 + b0 * b0 + b1 * b1; float s = (q[0] + q[1]) + (q[2] + q[3]);
                    s += __shfl_xor(s, 16); s += __shfl_xor(s, 32);
                    if (fq == 0) atomicAdd(ssq + (size_t)row * 2 + (pn >> 1), s);
                } else if (pn >= 10 && pn < 13) { a0 *= QS_NA; a1 *= QS_NA; b0 *= QS_NA; b1 *= QS_NA; }
                else if (pn == 19 && wc < 2 && u.pm < 32) { const int t = row & (SEQ - 1); rope8(a0, a1, fq, (float)(wc == 0 ? (t >> 6) : (t & 63))); }
                if (pn >= 13 && pn < 19) {
                    bf16_t* dst = (pn < 16 ? NKM : NVM) + ((size_t)key_slot(row) + (size_t)(2 * ((pn - 13) % 3)) * NKEY) * 128 + wc * 32 + 8 * fq;
                    *(u32x4*)dst = pack8(a0, a1); *(u32x4*)(dst + (size_t)NKEY * 128) = pack8(b0, b1);
                } else if (pn == 19) {
                    if (wc < 2) { bf16_t* dst = KM + (size_t)key_slot(row) * 192 + 128 + wc * 32 + 8 * fq; const u32x4 w = pack8(a0, a1);
#pragma unroll
                        for (int h = 0; h < 6; ++h) *(u32x4*)(dst + (size_t)h * NKEY * 192) = w; }
                } else {
                    bf16_t* p = Zp + (size_t)row * ZLD + colb;
                    *(u32x4*)p = pack8(a0, a1); *(u32x4*)(p + 128) = pack8(b0, b1);
                }
            }
    }
};
struct EpiQKV {
    bf16_t* O; const float* ssq; bf16_t* KM; bf16_t* VM;
    __device__ __forceinline__ void operator()(const AccT& acc, const Unit& u, int wr, int wc, int fr, int fq) const {
        const int pn = u.pn, colb = pn * 256 + wc * 32 + 8 * fq; const bool isq = pn < 6;
#pragma unroll
        for (int ai = 0; ai < 2; ++ai)
#pragma unroll
            for (int m = 0; m < 4; ++m) {
                const int row = u.pm * 256 + ai * 128 + wr * 64 + m * 16 + fr;
                float rs = __builtin_amdgcn_rsqf(ssq[(size_t)row * 2 + (isq ? 0 : 1)] * (1.0f / 512.0f) + RMS_EPS); if (isq) rs *= QS_MLA;
                f32x4 a0 = acc[ai][0][m][0] * rs, a1 = acc[ai][0][m][1] * rs, b0 = acc[ai][1][m][0] * rs, b1 = acc[ai][1][m][1] * rs;
                bf16_t* p = O + (size_t)row * QLD + colb;
                if (isq) {
                    *(u32x4*)p = pack8(a0, a1);
                    if (wc < 2) { if (u.pm < 32) { const int t = row & (SEQ - 1); rope8(b0, b1, fq, (float)(wc == 0 ? (t >> 6) : (t & 63))); } *(u32x4*)(p + 128) = pack8(b0, b1); }
                } else {
                    const size_t ks = (size_t)key_slot(row) + (size_t)(pn - 6) * NKEY;
                    *(u32x4*)(KM + ks * 192 + wc * 32 + 8 * fq) = pack8(a0, a1); *(u32x4*)(VM + ks * 128 + wc * 32 + 8 * fq) = pack8(b0, b1);
                }
            }
    }
};
struct EpiRes {
    const float* xlat; const float* xctx; const float* gate; float* Yp; float* YS;
    __device__ __forceinline__ void operator()(const AccT& acc, const Unit& u, int wr, int wc, int fr, int fq) const {
        const int bidx = u.pm < 32 ? (u.pm >> 3) : 4; const float* xr = u.pm < 32 ? xlat : xctx;
        const int colb = u.pn * 256 + wc * 32 + 8 * fq;
        const float* gp = gate + (size_t)bidx * MODLD + colb;
        const f32x4 g00 = *(const f32x4*)gp, g01 = *(const f32x4*)(gp + 4), g10 = *(const f32x4*)(gp + 128), g11 = *(const f32x4*)(gp + 132);
#pragma unroll
        for (int ai = 0; ai < 2; ++ai)
#pragma unroll
            for (int m = 0; m < 4; ++m) {
                const int row = u.pm * 256 + ai * 128 + wr * 64 + m * 16 + fr;
                const float* xp = xr + (size_t)row * DM + colb; float* yp = (u.pm < 32 || YS == nullptr) ? Yp + (size_t)row * DM + colb : YS + ((size_t)u.ks * NCTX + (row - NLAT)) * DM + colb;
                f32x4 x00 = {0.f, 0.f, 0.f, 0.f}, x01 = x00, x10 = x00, x11 = x00;
                if (u.kt0 == 0) { x00 = *(const f32x4*)xp; x01 = *(const f32x4*)(xp + 4); x10 = *(const f32x4*)(xp + 128); x11 = *(const f32x4*)(xp + 132); }
                *(f32x4*)yp = x00 * DN_ALPHA + g00 * acc[ai][0][m][0]; *(f32x4*)(yp + 4) = x01 * DN_ALPHA + g01 * acc[ai][0][m][1];
                *(f32x4*)(yp + 128) = x10 * DN_ALPHA + g10 * acc[ai][1][m][0]; *(f32x4*)(yp + 132) = x11 * DN_ALPHA + g11 * acc[ai][1][m][1];
            }
    }
};
struct EpiSwiGLU {
    bf16_t* H;
    __device__ __forceinline__ void operator()(const AccT& acc, const Unit& u, int wr, int wc, int fr, int fq) const {
        const int colb = u.pn * 128 + wc * 32 + 8 * fq;
#pragma unroll
        for (int ai = 0; ai < 2; ++ai)
#pragma unroll
            for (int m = 0; m < 4; ++m) {
                const int row = u.pm * 256 + ai * 128 + wr * 64 + m * 16 + fr;
                f32x4 h0, h1;
#pragma unroll
                for (int e = 0; e < 4; ++e) {
                    const float g0 = acc[ai][0][m][0][e], g1 = acc[ai][0][m][1][e];
                    h0[e] = g0 * __builtin_amdgcn_rcpf(1.0f + __builtin_amdgcn_exp2f(-g0 * LOG2E)) * acc[ai][1][m][0][e];
                    h1[e] = g1 * __builtin_amdgcn_rcpf(1.0f + __builtin_amdgcn_exp2f(-g1 * LOG2E)) * acc[ai][1][m][1][e];
                }
                *(u32x4*)(H + (size_t)row * FF + colb) = pack8(h0, h1);
            }
    }
};

struct AttnJob {
    const bf16_t* Q; const bf16_t* Kn; const bf16_t* Kr; const bf16_t* V; bf16_t* O;
    int ldq, ldk, ldkr, ldv, ldo;
    int q0, ctx_base, nctx_tiles, lat_base, nlat_tiles;
    int R0, krow_lo; const float* rpb;
};
__device__ __forceinline__ int crow(int i, int hi) { return (i & 3) + 8 * (i >> 2) + 4 * hi; }
__device__ __forceinline__ s16x4 vtr(const LAS unsigned char* p) { return __builtin_bit_cast(s16x4, __builtin_amdgcn_ds_read_tr16_b64_v4i16((LAS s16x4*)p)); }

template <int DQK, bool NA>
__device__ __forceinline__ void attn_unit(LAS unsigned char* lds, const AttnJob& J, const int tid) {
    constexpr int KSTR = DQK * 2 + 16, VSTR = 320, KBUF = 64 * KSTR, VBUF = 64 * VSTR, NS = DQK / 16, NKC = DQK / 64, NG = 2 * NS / 4;
    constexpr int BIAS_OFF = 2 * KBUF + 2 * VBUF;
    const int lane = tid & 63, l32 = lane & 31, hi = lane >> 5;
    const int wid = __builtin_amdgcn_readfirstlane(tid >> 6);
    bf16x8 qf[NS];
    { const bf16_t* qp = J.Q + (size_t)(J.q0 + wid * 32 + l32) * J.ldq + 8 * hi;
#pragma unroll
      for (int s = 0; s < NS; ++s) qf[s] = *(const bf16x8*)(qp + 16 * s); }
    LAS float* biasL = (LAS float*)(lds + BIAS_OFF) + 64;
    if (NA) { for (int i = tid; i < 64 + 15 * 31 + 128; i += 512) { const int j = i - 64; biasL[j] = (j >= 0 && j < 15 * 31) ? J.rpb[j] * LOG2E : 0.f; } }
    const int qc = 32 * (wid & 1) + l32, c0 = min(max(qc - 8, 0), 48), qr = J.R0 + (wid >> 1), r0 = min(max(qr - 4, 0), 24);
    f32x16 O[4];
#pragma unroll
    for (int d = 0; d < 4; ++d)
#pragma unroll
        for (int i = 0; i < 16; ++i) O[d][i] = 0.f;
    float mrun = -1e30f, lsum = 0.f;
    const int nt = J.nctx_tiles + J.nlat_tiles;
    u32x4 kreg[NKC], vreg[2];
#define ATT_TB(t) ((t) < J.nctx_tiles ? J.ctx_base + 64 * (t) : J.lat_base + 64 * ((t) - J.nctx_tiles))
#define ATT_LOAD(t) do { const int tb_ = ATT_TB(t); const bf16_t* kp_ = J.Kn + (size_t)(tb_ + (tid >> 3)) * J.ldk + (tid & 7) * 8; \
        kreg[0] = *(const u32x4*)kp_; kreg[1] = *(const u32x4*)(kp_ + 64); \
        if (DQK == 192) kreg[NKC - 1] = *(const u32x4*)(J.Kr + (size_t)(tb_ + (tid >> 3)) * J.ldkr + (tid & 7) * 8); \
        const bf16_t* vp_ = J.V + (size_t)(tb_ + (tid >> 3)) * J.ldv + (tid & 7) * 8; vreg[0] = *(const u32x4*)vp_; vreg[1] = *(const u32x4*)(vp_ + 64); } while (0)
#define ATT_STORE(buf) do { LAS unsigned char* kd_ = lds + (buf) * KBUF + (tid >> 3) * KSTR + (tid & 7) * 16; \
        _Pragma("unroll") for (int i_ = 0; i_ < NKC; ++i_) *(LAS u32x4*)(kd_ + 128 * i_) = kreg[i_]; \
        LAS unsigned char* vd_ = lds + 2 * KBUF + (buf) * VBUF + (tid >> 3) * VSTR + (tid & 7) * 16; *(LAS u32x4*)vd_ = vreg[0]; *(LAS u32x4*)(vd_ + 128) = vreg[1]; } while (0)
#define ATT_BAR() do { asm volatile("s_waitcnt lgkmcnt(0)" ::: "memory"); __builtin_amdgcn_s_barrier(); asm volatile("" ::: "memory"); } while (0)
#define ATT_KF(dst, g) do { _Pragma("unroll") for (int j_ = 0; j_ < 4; ++j_) { const int idx_ = 4 * (g) + j_; dst[j_] = *(const LAS bf16x8*)(Kb + (idx_ / NS) * 32 * KSTR + 32 * (idx_ % NS)); } } while (0)
#define ATT_VF(dst, g) do { _Pragma("unroll") for (int d_ = 0; d_ < 4; ++d_) { const LAS unsigned char* vp_ = Vb + (16 * (g)) * VSTR + d_ * 64; \
        const s16x4 lo_ = vtr(vp_), hh_ = vtr(vp_ + 8 * VSTR); dst[d_] = __builtin_shufflevector(lo_, hh_, 0, 1, 2, 3, 4, 5, 6, 7); } } while (0)
    ATT_LOAD(0);
#pragma unroll 1
    for (int t = 0; t < nt; ++t) {
        const int buf = t & 1;
        ATT_STORE(buf);
        if (t + 1 < nt) ATT_LOAD(t + 1);
        ATT_BAR();
        bool active = true; int dr = 0;
        if (NA && t >= J.nctx_tiles) { const int kr = J.krow_lo + (t - J.nctx_tiles); active = (kr >= r0) && (kr < r0 + 8); dr = kr - qr + 7; }
        if (active) {
            const LAS unsigned char* Kb = lds + buf * KBUF + l32 * KSTR + 16 * hi;
            const LAS unsigned char* Vb = lds + 2 * KBUF + buf * VBUF + (4 * hi + ((lane & 15) >> 2)) * VSTR + ((lane >> 4) & 1) * 32 + (lane & 3) * 8;
            f32x16 S[2];
#pragma unroll
            for (int kb = 0; kb < 2; ++kb)
#pragma unroll
                for (int i = 0; i < 16; ++i) S[kb][i] = 0.f;
            bf16x8 fa[4], fb[4];
            ATT_KF(fa, 0);
#pragma unroll
            for (int g = 0; g < NG; ++g) {
                if (g + 1 < NG) { if (g & 1) ATT_KF(fa, g + 1); else ATT_KF(fb, g + 1); }
                __builtin_amdgcn_sched_barrier(0);
#pragma unroll
                for (int j = 0; j < 4; ++j) { const int idx = 4 * g + j; S[idx / NS] = __builtin_amdgcn_mfma_f32_32x32x16_bf16((g & 1) ? fb[j] : fa[j], qf[idx % NS], S[idx / NS], 0, 0, 0); }
                __builtin_amdgcn_sched_barrier(0);
            }
            ATT_VF(fa, 0);
            if (NA && t >= J.nctx_tiles) {
                int wb = 4 * hi - c0; asm volatile("" : "+v"(wb));
                const LAS float* brow = biasL + dr * 31 + 15 - qc + 4 * hi;
#pragma unroll
                for (int kb = 0; kb < 2; ++kb)
#pragma unroll
                    for (int i = 0; i < 16; ++i) { const int kcc = 32 * kb + (i & 3) + 8 * (i >> 2); const bool inw = (unsigned)(kcc + wb) < 16u;
                        S[kb][i] = (S[kb][i] + brow[kcc]) + (inw ? 0.f : -1e30f); }
            }
            float mx = S[0][0];
#pragma unroll
            for (int i = 1; i < 16; ++i) mx = fmaxf(mx, S[0][i]);
#pragma unroll
            for (int i = 0; i < 16; ++i) mx = fmaxf(mx, S[1][i]);
            mx = fmaxf(mx, __shfl_xor(mx, 32));
            const float mnew = fmaxf(mrun, mx), alpha = __builtin_amdgcn_exp2f(mrun - mnew); mrun = mnew;
            float ps = 0.f;
#pragma unroll
            for (int kb = 0; kb < 2; ++kb)
#pragma unroll
                for (int i = 0; i < 16; ++i) { S[kb][i] = __builtin_amdgcn_exp2f(S[kb][i] - mnew); ps += S[kb][i]; }
            lsum = lsum * alpha + ps;
            if (__builtin_amdgcn_ballot_w64(alpha != 1.0f) != 0ull) {
#pragma unroll
                for (int d = 0; d < 4; ++d)
#pragma unroll
                    for (int i = 0; i < 16; ++i) O[d][i] *= alpha;
            }
#pragma unroll
            for (int g = 0; g < 4; ++g) {
                if (g + 1 < 4) { if (g & 1) ATT_VF(fa, g + 1); else ATT_VF(fb, g + 1); }
                const int kb = g >> 1, s = g & 1;
                u32x4 pw; pw.x = cvt_pk_bf16(S[kb][8 * s], S[kb][8 * s + 1]); pw.y = cvt_pk_bf16(S[kb][8 * s + 2], S[kb][8 * s + 3]); pw.z = cvt_pk_bf16(S[kb][8 * s + 4], S[kb][8 * s + 5]); pw.w = cvt_pk_bf16(S[kb][8 * s + 6], S[kb][8 * s + 7]);
                const bf16x8 pf = __builtin_bit_cast(bf16x8, pw);
                __builtin_amdgcn_sched_barrier(0);
#pragma unroll
                for (int d = 0; d < 4; ++d) O[d] = __builtin_amdgcn_mfma_f32_32x32x16_bf16((g & 1) ? fb[d] : fa[d], pf, O[d], 0, 0, 0);
                __builtin_amdgcn_sched_barrier(0);
            }
        }
    }
#undef ATT_TB
#undef ATT_LOAD
#undef ATT_STORE
#undef ATT_BAR
#undef ATT_KF
#undef ATT_VF
    lsum += __shfl_xor(lsum, 32);
    const float inv = 1.0f / lsum;
    bf16_t* op = J.O + (size_t)(J.q0 + wid * 32 + l32) * J.ldo + 4 * hi;
#pragma unroll
    for (int d = 0; d < 4; ++d)
#pragma unroll
        for (int j = 0; j < 4; ++j) { u32x2 w; w.x = cvt_pk_bf16(O[d][4 * j] * inv, O[d][4 * j + 1] * inv); w.y = cvt_pk_bf16(O[d][4 * j + 2] * inv, O[d][4 * j + 3] * inv);
            *(u32x2*)(op + 32 * d + 8 * j) = w; }
}

#define XB_TMO      128
#define XB_XCNT(j)  (256  + 64 * (j))
#define XB_XSUB(j)  (1280 + 64 * (j))
#define XB_XGEN(j)  (2304 + 64 * (j))
#define XB_TOP      3328
#define XB_TOPGEN   3392
#define XCD_BAR_WORDS 3456
#define XB_SPIN_CAP (1u << 20)
__device__ __forceinline__ unsigned xb_ld(unsigned* p)              { return __hip_atomic_load(p, __ATOMIC_RELAXED, __HIP_MEMORY_SCOPE_AGENT); }
__device__ __forceinline__ unsigned xb_add(unsigned* p, unsigned v) { return __hip_atomic_fetch_add(p, v, __ATOMIC_RELAXED, __HIP_MEMORY_SCOPE_AGENT); }
__device__ __forceinline__ unsigned xb_xcc_id() { return (unsigned)__builtin_amdgcn_s_getreg((3 << 11) | 20) & 0xFu; }
#define XB_SPIN(cond, bar) do { unsigned _sp = 0; while (cond) { __builtin_amdgcn_s_sleep(1); \
    if ((++_sp & 255u) == 0u) { if (xb_ld(&(bar)[XB_TMO])) break; if (_sp > XB_SPIN_CAP) { atomicAdd(&(bar)[XB_TMO], 1u); break; } } } } while (0)
struct XcdBarrier { unsigned* bar; unsigned x; volatile LAS unsigned* st; };
__device__ __forceinline__ XcdBarrier xcd_barrier_post(unsigned* bar, volatile LAS unsigned* st) {
    XcdBarrier b; b.bar = bar; b.x = xb_xcc_id(); b.st = st;
    if (threadIdx.x == 0) (void)xb_add(&bar[XB_XCNT(b.x)], 1u);
    return b;
}
__device__ __forceinline__ void xcd_barrier_complete(unsigned* bar, unsigned x, unsigned& nloc, unsigned& nx) {
    const unsigned G = gridDim.x * gridDim.y * gridDim.z;
    unsigned sum, cnt, mine, sp = 0u;
    for (;;) {
        sum = 0u; cnt = 0u; mine = 0u;
#pragma unroll
        for (unsigned j = 0; j < 16; ++j) { const unsigned c = xb_ld(&bar[XB_XCNT(j)]); sum += c; cnt += (c > 0u) ? 1u : 0u; mine = (j == x) ? c : mine; }
        if (sum == G) break;
        __builtin_amdgcn_s_sleep(1);
        if ((++sp & 255u) == 0u) { if (xb_ld(&bar[XB_TMO])) break; if (sp > XB_SPIN_CAP) { atomicAdd(&bar[XB_TMO], 1u); break; } }
    }
    nloc = mine > 0u ? mine : 1u; nx = cnt > 0u ? cnt : 1u;
}
__device__ __forceinline__ void xcd_barrier(const XcdBarrier& b) {
    asm volatile("s_waitcnt vmcnt(0)" ::: "memory");
    __syncthreads();
    if (threadIdx.x == 0) {
        unsigned* bar = b.bar;
        __builtin_amdgcn_s_waitcnt(0);
        unsigned nloc = b.st[0], nx = b.st[1];
        if (nloc == 0u) { xcd_barrier_complete(bar, b.x, nloc, nx); b.st[0] = nloc; b.st[1] = nx; }
        const unsigned old = xb_add(&bar[XB_XSUB(b.x)], 1u);
        const unsigned gen = old / nloc;
        if (old + 1u == (gen + 1u) * nloc) {
            __builtin_amdgcn_fence(__ATOMIC_RELEASE, "agent");
            asm volatile("s_waitcnt vmcnt(0)" ::: "memory");
            const unsigned og = xb_add(&bar[XB_TOP], 1u);
            const unsigned tg = og / nx;
            if (og + 1u == (tg + 1u) * nx) xb_add(&bar[XB_TOPGEN], 1u);
            else XB_SPIN(xb_ld(&bar[XB_TOPGEN]) == tg, bar);
            __builtin_amdgcn_fence(__ATOMIC_ACQUIRE, "agent");
            xb_add(&bar[XB_XGEN(b.x)], 1u);
            asm volatile("s_waitcnt vmcnt(0)" ::: "memory");
        } else {
            XB_SPIN(xb_ld(&bar[XB_XGEN(b.x)]) == gen, bar);
            __builtin_amdgcn_fence(__ATOMIC_ACQUIRE, "agent");
            asm volatile("s_waitcnt vmcnt(0)" ::: "memory");
        }
    }
    __syncthreads();
}

struct Args {
    const float* in[21]; float* out; unsigned char* ws; int ph_lo, ph_hi;
};
constexpr int NPHASE = 18;
#ifndef PROBE_MASK
#define PROBE_MASK 0x0
#endif
#ifndef MK_EN
#define MK_EN 0xFFFF
#endif
#define EN(k) (((MK_EN) >> (k)) & 1)

__device__ __forceinline__ void transpose_item(const float* W, int N, int K, bf16_t* WT, int dst_row0, int k0, int n0, const float* kscale, LAS float* scr, int lane) {
#pragma unroll 8
    for (int i = 0; i < 32; ++i) { const int kk = 2 * i + (lane >> 5); float v = W[(size_t)(k0 + kk) * N + n0 + (lane & 31)]; if (kscale) v *= kscale[k0 + kk]; scr[kk * 33 + (lane & 31)] = v; }
    LDS_WAIT();
    const int c = lane & 7;
#pragma unroll
    for (int j = 0; j < 4; ++j) { const int n = (lane >> 3) + 8 * j; const LAS float* s = scr + (8 * c) * 33 + n;
        u32x4 o; o.x = cvt_pk_bf16(s[0 * 33], s[1 * 33]); o.y = cvt_pk_bf16(s[2 * 33], s[3 * 33]); o.z = cvt_pk_bf16(s[4 * 33], s[5 * 33]); o.w = cvt_pk_bf16(s[6 * 33], s[7 * 33]);
        *(u32x4*)(WT + (size_t)(dst_row0 + n) * K + k0 + 8 * c) = o; }
    LDS_WAIT();
}

template <bool DO_LN>
__device__ __forceinline__ void row_pass(const float* yrow, const float* lg, const float* lb, float* xout, bf16_t* xm, const float* sh, const float* sc, int lane, int nslab = 1) {
    f32x4 v[8];
#pragma unroll
    for (int j = 0; j < 8; ++j) v[j] = *(const f32x4*)(yrow + 4 * lane + 256 * j);
    for (int sl = 1; sl < nslab; ++sl) {
#pragma unroll
        for (int j = 0; j < 8; ++j) v[j] += *(const f32x4*)(yrow + (size_t)sl * NCTX * DM + 4 * lane + 256 * j);
    }
    if (DO_LN) {
        float s = 0.f;
#pragma unroll
        for (int j = 0; j < 8; ++j) s += (v[j][0] + v[j][1]) + (v[j][2] + v[j][3]);
        const float mean = wave_sum(s) * (1.0f / DM); float q = 0.f;
#pragma unroll
        for (int j = 0; j < 8; ++j) { v[j] = v[j] - mean; q += (v[j][0] * v[j][0] + v[j][1] * v[j][1]) + (v[j][2] * v[j][2] + v[j][3] * v[j][3]); }
        const float rstd = 1.0f / sqrtf(wave_sum(q) * (1.0f / DM) + LN_EPS);
#pragma unroll
        for (int j = 0; j < 8; ++j) { const f32x4 g = *(const f32x4*)(lg + 4 * lane + 256 * j), b = *(const f32x4*)(lb + 4 * lane + 256 * j); v[j] = v[j] * rstd * g + b; }
        if (xout) {
#pragma unroll
            for (int j = 0; j < 8; ++j) *(f32x4*)(xout + 4 * lane + 256 * j) = v[j];
        }
    }
    if (xm) {
#pragma unroll
        for (int j = 0; j < 8; ++j) { const f32x4 a = *(const f32x4*)(sc + 4 * lane + 256 * j), b = *(const f32x4*)(sh + 4 * lane + 256 * j); const f32x4 o = v[j] * (a + 1.0f) + b;
            u32x2 w; w.x = cvt_pk_bf16(o[0], o[1]); w.y = cvt_pk_bf16(o[2], o[3]); *(u32x2*)(xm + 4 * lane + 256 * j) = w; }
    }
}

typedef const __attribute__((address_space(4))) Args* KArgP;
__device__ __forceinline__ void run_phase(const int ph, LAS unsigned char* lds, const KArgP ap0, const int G, const int bx, const int rep) {
        int tid = threadIdx.x; asm volatile("" : "+v"(tid));
        const int lane = tid & 63, wave = __builtin_amdgcn_readfirstlane(tid >> 6);
        KArgP ap = ap0; asm volatile("" : "+s"(ap));
        unsigned char* ws = ap->ws;
#define x_in (ap->in[0])
#define c_in (ap->in[1])
#define ctx_in (ap->in[2])
#define cctx_in (ap->in[3])
#define ada_w (ap->in[4])
#define ada_b (ap->in[5])
#define w_in (ap->in[6])
#define q_norm (ap->in[7])
#define wq_b (ap->in[8])
#define kv_norm (ap->in[9])
#define wkv_b (ap->in[10])
#define conv_w (ap->in[11])
#define na_rpb (ap->in[12])
#define w_out (ap->in[13])
#define ln1_g (ap->in[14])
#define ln1_b (ap->in[15])
#define w_gate (ap->in[16])
#define w_up (ap->in[17])
#define w_down (ap->in[18])
#define ln2_g (ap->in[19])
#define ln2_b (ap->in[20])
#define ctl ((unsigned*)(ws + WS_CTL))
#define SSQ ((float*)(ws + WS_SSQ))
#define MOD ((float*)(ws + WS_MOD))
#define XM ((bf16_t*)(ws + WS_XM))
#define Z ((bf16_t*)(ws + WS_Z))
#define QKV ((bf16_t*)(ws + WS_QKV))
#define HB ((bf16_t*)(ws + WS_H))
#define MIX ((bf16_t*)(ws + WS_MIX))
#define Y ((float*)(ws + WS_Y))
#define XMID ((float*)(ws + WS_XMID))
#define X1 ((float*)(ws + WS_X1))
#define YSLAB ((float*)(ws + WS_YS))
#define KMB ((bf16_t*)(ws + WS_KM))
#define VMB ((bf16_t*)(ws + WS_VM))
#define NKMB ((bf16_t*)(ws + WS_NKM))
#define NVMB ((bf16_t*)(ws + WS_NVM))
        if (ph == 0) { if (EN(0)) {
            if (rep == 0) for (int i = bx * 512 + tid; i < 8192; i += G * 512) ctl[i] = 0u;
            if (rep == 0) for (int i = bx * 512 + tid; i < 2 * MTOT * 2; i += G * 512) SSQ[i] = 0.f;
            {
                LAS float* sL = (LAS float*)lds; LAS float* red = (LAS float*)(lds + 40960);
                if (bx < 192) {
                    for (int i = tid; i < 5 * DM; i += 512) { const int b = i >> 11, k = i & (DM - 1); const float v = (b < 4) ? c_in[b * DM + k] : cctx_in[k]; sL[i] = v / (1.0f + __expf(-v)); }
                    __syncthreads();
                    for (int job = bx; job < 192; job += G) {
                        const int l = job / 96, col0 = (job % 96) * 128, c4 = tid & 31, ks = tid >> 5;
                        const float* Wp = ada_w + ((size_t)l * DM + ks * 128) * MODLD + col0 + c4 * 4;
                        f32x4 a0 = {0.f, 0.f, 0.f, 0.f}, a1 = a0, a2 = a0, a3 = a0, a4 = a0;
#pragma unroll 8
                        for (int k = 0; k < 128; ++k) { const f32x4 w = *(const f32x4*)(Wp + (size_t)k * MODLD); const int kk = ks * 128 + k;
                            a0 += w * sL[kk]; a1 += w * sL[DM + kk]; a2 += w * sL[2 * DM + kk]; a3 += w * sL[3 * DM + kk]; a4 += w * sL[4 * DM + kk]; }
                        *(LAS f32x4*)(red + (ks * 5 + 0) * 128 + c4 * 4) = a0; *(LAS f32x4*)(red + (ks * 5 + 1) * 128 + c4 * 4) = a1; *(LAS f32x4*)(red + (ks * 5 + 2) * 128 + c4 * 4) = a2;
                        *(LAS f32x4*)(red + (ks * 5 + 3) * 128 + c4 * 4) = a3; *(LAS f32x4*)(red + (ks * 5 + 4) * 128 + c4 * 4) = a4;
                        __syncthreads();
                        for (int i = tid; i < 640; i += 512) { const int b = i >> 7, cc = i & 127; float s = ada_b[(size_t)l * MODLD + col0 + cc];
#pragma unroll
                            for (int k2 = 0; k2 < 16; ++k2) s += red[(k2 * 5 + b) * 128 + cc];
                            MOD[((size_t)l * 5 + b) * MODLD + col0 + cc] = s; }
                        __syncthreads();
                    }
                }
                __syncthreads();
            }
            {
                LAS float* scr = (LAS float*)(lds + wave * 16384);
                const int gw = bx * 8 + wave, NGW = G * 8;
                constexpr int I_IN = 32 * 154, I_Q = 8 * 36, I_KV = 8 * 48, I_O = 32 * 64, I_G = 32 * 176, I_D = 88 * 64, I_LAYER = I_IN + I_Q + I_KV + I_O + 2 * I_G + I_D;
                for (int it = gw; it < 2 * I_LAYER; it += NGW) {
                    const int l = it / I_LAYER; int r = it % I_LAYER;
                    unsigned char* wl = ws + WS_W + (size_t)l * W_LAYER;
                    if (r < I_IN) { const int kb = r / 154, n0 = (r % 154) * 32; const int d0 = n0 < 1024 ? n0 : (n0 < 1088 ? n0 + 3840 : n0 - 64);
                        transpose_item(w_in + (size_t)l * DM * INDIM, INDIM, DM, (bf16_t*)(wl + W_IN), d0, kb * 64, n0, nullptr, scr, lane); continue; } r -= I_IN;
                    if (r < I_Q) { const int kb = r / 36, n0 = (r % 36) * 32; const int d0 = (n0 / 192) * 256 + (n0 % 192);
                        transpose_item(wq_b + (size_t)l * 512 * 1152, 1152, 512, (bf16_t*)(wl + W_QKV), d0, kb * 64, n0, q_norm + l * 512, scr, lane); continue; } r -= I_Q;
                    if (r < I_KV) { const int kb = r / 48, n0 = (r % 48) * 32;
                        transpose_item(wkv_b + (size_t)l * 512 * 1536, 1536, 512, (bf16_t*)(wl + W_QKV), 1536 + n0, kb * 64, n0, kv_norm + l * 512, scr, lane); continue; } r -= I_KV;
                    if (r < I_O) { const int kb = r / 64, n0 = (r % 64) * 32;
                        transpose_item(w_out + (size_t)l * DM * DM, DM, DM, (bf16_t*)(wl + W_O), n0, kb * 64, n0, nullptr, scr, lane); continue; } r -= I_O;
                    if (r < I_G) { const int kb = r / 176, n0 = (r % 176) * 32; const int d0 = (n0 / 128) * 256 + (n0 % 128);
                        transpose_item(w_gate + (size_t)l * DM * FF, FF, DM, (bf16_t*)(wl + W_GU), d0, kb * 64, n0, nullptr, scr, lane); continue; } r -= I_G;
                    if (r < I_G) { const int kb = r / 176, n0 = (r % 176) * 32; const int d0 = (n0 / 128) * 256 + 128 + (n0 % 128);
                        transpose_item(w_up + (size_t)l * DM * FF, FF, DM, (bf16_t*)(wl + W_GU), d0, kb * 64, n0, nullptr, scr, lane); continue; } r -= I_G;
                    { const int kb = r / 64, n0 = (r % 64) * 32;
                        transpose_item(w_down + (size_t)l * FF * DM, DM, FF, (bf16_t*)(wl + W_D), n0, kb * 64, n0, nullptr, scr, lane); }
                }
                const u32x4 z4 = {0u, 0u, 0u, 0u};
                for (int i = bx * 512 + tid; i < 2 * (192 * 256 + 384 * 64); i += G * 512) {
                    const int l = i / (192 * 256 + 384 * 64); int r = i % (192 * 256 + 384 * 64); unsigned char* wl = ws + WS_W + (size_t)l * W_LAYER;
                    if (r < 192 * 256) { *(u32x4*)((bf16_t*)(wl + W_IN) + (size_t)(4928 + r / 256) * DM + (r % 256) * 8) = z4; }
                    else { r -= 192 * 256; const int rr = r / 64, h = rr / 64, j = rr % 64; *(u32x4*)((bf16_t*)(wl + W_QKV) + (size_t)(h * 256 + 192 + j) * 512 + (r % 64) * 8) = z4; }
                }
            }
        } } else if (ph == 1) { if (EN(1))
            for (int row = bx * 8 + wave; row < MTOT; row += G * 8) {
                const int bidx = row < NLAT ? (row >> 11) : 4; const float* src = row < NLAT ? x_in + (size_t)row * DM : ctx_in + (size_t)(row - NLAT) * DM;
                const float* mod = MOD + (size_t)bidx * MODLD;
                row_pass<false>(src, nullptr, nullptr, nullptr, XM + (size_t)row * DM, mod, mod + DM, lane);
            }
        } else {
            const int l = (ph - 2) >> 3, sub = (ph - 2) & 7; const bool last = (l == 1);
            unsigned char* wl = ws + WS_W + (size_t)l * W_LAYER;
            float* ssq = SSQ + (size_t)l * MTOT * 2;
            const float* modl = MOD + (size_t)l * 5 * MODLD;
            const int nMpost = last ? 32 : 36;
            if (sub == 0) { if (EN(2)) {
                pg8::Gemm g{XM, (const bf16_t*)(wl + W_IN), DM, DM, DM, 1 << 30, 0}; pg8::StaticOrder S; S.init(36, 20, G, bx, DM / 64);
                EpiZ E{Z, ssq, KMB, NKMB, NVMB}; pg8::gemm_phase(lds, g, S, E, tid);
            } } else if (sub == 1) { if (EN(3)) {
                pg8::Gemm g{Z + ZC_Q, (const bf16_t*)(wl + W_QKV), ZLD, 512, 512, 6, 512 * 2}; pg8::StaticOrder S; S.init(36, 12, G, bx, 512 / 64);
                EpiQKV E{QKV, ssq, KMB, VMB}; pg8::gemm_phase(lds, g, S, E, tid);
            } } else if (sub == 2) { if (EN(4)) {
                unsigned* ctr0 = ctl + 64 * (8 + 8 * (l + 2 * rep));
                const int nctxq = last ? 0 : 3, nconv = last ? 16 : 18;
                const int J_NA = 24, J_MC = 48, J_NC = J_MC + nctxq, J_CV = J_NC + nctxq, J_END = J_CV + nconv;
                LAS int* jobslot = (LAS int*)(lds + JOB_OFF);
                const int myx = (int)(xb_xcc_id() & 7u);
                int xi = 0;
                for (;;) {
                    const int xq = (myx + xi) & 7;
                    __syncthreads();
                    if (tid == 0) *jobslot = (int)atomicAdd(ctr0 + 64 * xq, 1u);
                    __syncthreads();
                    const int job = __builtin_amdgcn_readfirstlane(*jobslot);
                    if (job >= J_END) { if (++xi == 8) break; continue; }
                    int tj = tid; asm volatile("" : "+v"(tj));
                    if (job < J_CV) {
                        AttnJob J; J.ldo = DM; J.nctx_tiles = 4;
                        const bool ismla = (job < J_NA) || (job >= J_MC && job < J_NC);
                        int b, h, sub;
                        {
                            int pair;
                            if (job < J_NA) { pair = xq + 8 * (job >> 3); sub = job & 7; }
                            else if (job < J_MC) { pair = xq + 8 * ((job - J_NA) >> 3); sub = (job - J_NA) & 7; }
                            else { pair = xq + 8 * ((job < J_NC) ? job - J_MC : job - J_NC); sub = -1; }
                            b = pair / 6; h = pair % 6;
                        }
                        J.ctx_base = 0; J.q0 = sub < 0 ? NLAT + b * CTXL : b * SEQ + sub * 256;
                        if (ismla) {
                            J.Q = QKV + h * 256; J.ldq = QLD; J.Kn = KMB + (size_t)(b * 6 + h) * NKEY * 192; J.ldk = 192; J.Kr = J.Kn + 128; J.ldkr = 192; J.V = VMB + (size_t)(b * 6 + h) * NKEY * 128; J.ldv = 128;
                            J.O = MIX + h * 128; J.lat_base = CTXL; J.nlat_tiles = sub < 0 ? 0 : 32; J.R0 = 0; J.krow_lo = 0; J.rpb = nullptr;
                            if (EN(10)) attn_unit<192, false>(lds, J, tj);
                        } else {
                            const int R0 = sub < 0 ? 0 : 4 * sub, klo = min(max(R0 - 4, 0), 24), khi = min(max(R0 - 1, 0), 24) + 7;
                            J.Q = Z + ZC_NQ + h * 128; J.ldq = ZLD; J.Kn = NKMB + (size_t)(b * 6 + h) * NKEY * 128; J.ldk = 128; J.Kr = nullptr; J.ldkr = 0; J.V = NVMB + (size_t)(b * 6 + h) * NKEY * 128; J.ldv = 128;
                            J.O = MIX + 1280 + h * 128; J.lat_base = CTXL + 64 * klo; J.nlat_tiles = sub < 0 ? 0 : khi - klo + 1;
                            J.R0 = R0; J.krow_lo = klo; J.rpb = na_rpb + ((size_t)l * 6 + h) * 15 * 31;
                            if (EN(11)) attn_unit<128, true>(lds, J, tj);
                        }
                    } else {
                        const int cj = xq + 8 * (job - J_CV); const float* cw = conv_w + (size_t)l * 3 * 512;
                        for (int it = tj; it < 64 * 64; it += 512) {
                            const int row = cj * 64 + (it >> 6), ch = (it & 63) * 8;
                            const int pos = row < NLAT ? (row & (SEQ - 1)) : ((row - NLAT) & (CTXL - 1)), len = row < NLAT ? SEQ : CTXL;
                            const bf16_t* zr = Z + (size_t)row * ZLD;
                            const u32x4 zz = {0u, 0u, 0u, 0u};
                            const u32x4 gb = *(const u32x4*)(zr + ZC_CB + ch);
                            const u32x4 c1 = *(const u32x4*)(zr + ZC_CC + ch), h1 = *(const u32x4*)(zr + ZC_CH + ch);
                            const u32x4 c0v = pos > 0 ? *(const u32x4*)(zr - ZLD + ZC_CC + ch) : zz, h0v = pos > 0 ? *(const u32x4*)(zr - ZLD + ZC_CH + ch) : zz;
                            const u32x4 c2 = pos < len - 1 ? *(const u32x4*)(zr + ZLD + ZC_CC + ch) : zz, h2 = pos < len - 1 ? *(const u32x4*)(zr + ZLD + ZC_CH + ch) : zz;
                            const f32x4 w0a = *(const f32x4*)(cw + ch), w0b = *(const f32x4*)(cw + ch + 4), w1a = *(const f32x4*)(cw + 512 + ch), w1b = *(const f32x4*)(cw + 512 + ch + 4);
                            const f32x4 w2a = *(const f32x4*)(cw + 1024 + ch), w2b = *(const f32x4*)(cw + 1024 + ch + 4);
                            u32x4 o;
#pragma unroll
                            for (int e = 0; e < 4; ++e) {
                                const float wl0 = e < 2 ? w0a[2 * e] : w0b[2 * e - 4], wh0 = e < 2 ? w0a[2 * e + 1] : w0b[2 * e - 3];
                                const float wl1 = e < 2 ? w1a[2 * e] : w1b[2 * e - 4], wh1 = e < 2 ? w1a[2 * e + 1] : w1b[2 * e - 3];
                                const float wl2 = e < 2 ? w2a[2 * e] : w2b[2 * e - 4], wh2 = e < 2 ? w2a[2 * e + 1] : w2b[2 * e - 3];
                                const float ylo = bflo(c0v[e]) * bflo(h0v[e]) * wl0 + bflo(c1[e]) * bflo(h1[e]) * wl1 + bflo(c2[e]) * bflo(h2[e]) * wl2;
                                const float yhi = bfhi(c0v[e]) * bfhi(h0v[e]) * wh0 + bfhi(c1[e]) * bfhi(h1[e]) * wh1 + bfhi(c2[e]) * bfhi(h2[e]) * wh2;
                                o[e] = cvt_pk_bf16(bflo(gb[e]) * ylo, bfhi(gb[e]) * yhi);
                            }
                            *(u32x4*)(MIX + (size_t)row * DM + 768 + ch) = o;
                        }
                    }
                }
            } } else if (sub == 3) { if (EN(5)) {
                pg8::Gemm g{MIX, (const bf16_t*)(wl + W_O), DM, DM, DM, 1 << 30, 0};
                if (!last) { pg8::SplitOrder S; S.init(8, G, bx, DM / 64, 4, 4); EpiRes E{x_in, ctx_in - (size_t)NLAT * DM, modl + 2 * DM, Y, YSLAB}; pg8::gemm_phase(lds, g, S, E, tid); }
                else { pg8::StaticOrder S; S.init(32, 8, G, bx, DM / 64); EpiRes E{X1, X1, modl + 2 * DM, Y, nullptr}; pg8::gemm_phase(lds, g, S, E, tid); }
            } } else if (sub == 4) { if (EN(6)) {
                for (int row = bx * 8 + wave; row < nMpost * 256; row += G * 8) {
                    const int bidx = row < NLAT ? (row >> 11) : 4; const float* mod = modl + (size_t)bidx * MODLD;
                    const bool slab = row >= NLAT;
                    row_pass<true>(slab ? YSLAB + (size_t)(row - NLAT) * DM : Y + (size_t)row * DM, ln1_g + l * DM, ln1_b + l * DM, XMID + (size_t)row * DM, XM + (size_t)row * DM, mod + 3 * DM, mod + 4 * DM, lane, slab ? 8 : 1);
                }
            } } else if (sub == 5) { if (EN(7)) {
                pg8::Gemm g{XM, (const bf16_t*)(wl + W_GU), DM, DM, DM, 1 << 30, 0}; pg8::StaticOrder S; S.init(nMpost, 44, G, bx, DM / 64);
                EpiSwiGLU E{HB}; pg8::gemm_phase(lds, g, S, E, tid);
            } } else if (sub == 6) { if (EN(8)) {
                pg8::Gemm g{HB, (const bf16_t*)(wl + W_D), FF, FF, FF, 1 << 30, 0}; EpiRes E{XMID, XMID, modl + 5 * DM, Y, last ? nullptr : YSLAB};
                if (!last) { pg8::SplitOrder S; S.init(8, G, bx, FF / 64, 12, 10); pg8::gemm_phase(lds, g, S, E, tid); }
                else { pg8::StaticOrder S; S.init(32, 8, G, bx, FF / 64); pg8::gemm_phase(lds, g, S, E, tid); }
            } } else { if (EN(9)) {
                for (int row = bx * 8 + wave; row < nMpost * 256; row += G * 8) {
                    const int bidx = row < NLAT ? (row >> 11) : 4;
                    if (!last) { const float* mod = MOD + (size_t)(5 + bidx) * MODLD; const bool slab = row >= NLAT;
                        row_pass<true>(slab ? YSLAB + (size_t)(row - NLAT) * DM : Y + (size_t)row * DM, ln2_g + l * DM, ln2_b + l * DM, X1 + (size_t)row * DM, XM + (size_t)row * DM, mod, mod + DM, lane, slab ? 8 : 1); }
                    else row_pass<true>(Y + (size_t)row * DM, ln2_g + l * DM, ln2_b + l * DM, ap->out + (size_t)row * DM, nullptr, nullptr, nullptr, lane);
                }
            } }
        }
}
__global__ void __launch_bounds__(512, 2) mega_fwd(Args args) {
    extern __shared__ __attribute__((aligned(16))) unsigned char lds_raw[];
    LAS unsigned char* lds = (LAS unsigned char*)lds_raw;
    cg::grid_group grid = cg::this_grid();
    const int G = gridDim.x, bx = blockIdx.x;
    const KArgP ap0 = (KArgP)__builtin_amdgcn_kernarg_segment_ptr();
    const int lo = ap0->ph_lo, hi_ph = ap0->ph_hi;
    volatile LAS unsigned* bst = (volatile LAS unsigned*)(lds + JOB_OFF + 64);
    if (threadIdx.x == 0) { bst[0] = 0u; bst[1] = 0u; }
    __syncthreads();
    XcdBarrier xb; xb.bar = (unsigned*)(ap0->ws + WS_CTL) + 4096; xb.x = 0; xb.st = bst;
#define RUN(k) if (lo <= (k) && (k) < hi_ph) { run_phase((k), lds, ap0, G, bx, 0); if (((PROBE_MASK) >> (k)) & 1) { if ((k) != lo) xcd_barrier(xb); else __syncthreads(); run_phase((k), lds, ap0, G, bx, 1); } if ((k) + 1 < hi_ph) { if ((k) == lo) { grid.sync(); xb = xcd_barrier_post(xb.bar, bst); } else xcd_barrier(xb); } }
    RUN(0) RUN(1) RUN(2) RUN(3) RUN(4) RUN(5) RUN(6) RUN(7) RUN(8) RUN(9) RUN(10) RUN(11) RUN(12) RUN(13) RUN(14) RUN(15) RUN(16) RUN(17)
#undef RUN
}

#ifndef MK_PER_PHASE
#define MK_PER_PHASE 0
#endif
extern "C" void kernel_launch(void* const* d_in, const int* in_sizes, int n_in, void* d_out, int out_size, void* d_ws, size_t ws_size, hipStream_t stream) {
    static int grid = 0;
    if (grid == 0) {
        if (n_in != 21 || ws_size < WS_END) { fprintf(stderr, "kernel_launch: expected 21 inputs and >= %zu bytes of workspace; got %d, %zu\n", (size_t)WS_END, n_in, ws_size); grid = -1; return; }
        int dev = 0, cus = 0, per_cu = 0;
        (void)hipGetDevice(&dev); (void)hipDeviceGetAttribute(&cus, hipDeviceAttributeMultiprocessorCount, dev);
        if (hipFuncSetAttribute((const void*)mega_fwd, hipFuncAttributeMaxDynamicSharedMemorySize, LDS_BYTES) != hipSuccess) { fprintf(stderr, "kernel_launch: hipFuncSetAttribute failed\n"); grid = -1; return; }
        if (hipOccupancyMaxActiveBlocksPerMultiprocessor(&per_cu, (const void*)mega_fwd, 512, LDS_BYTES) != hipSuccess || per_cu < 1) { fprintf(stderr, "kernel_launch: occupancy query says %d blocks per CU\n", per_cu); per_cu = 1; }
        (void)hipGetLastError();
        grid = cus;
        if (grid > cus * per_cu) grid = cus * per_cu;
    }
    if (grid < 0) return;
    Args a{};
    for (int i = 0; i < 21; ++i) a.in[i] = (const float*)d_in[i];
    a.out = (float*)d_out; a.ws = (unsigned char*)d_ws;
#if MK_PER_PHASE
    for (int ph = 0; ph < NPHASE; ++ph) { a.ph_lo = ph; a.ph_hi = ph + 1; void* kargs[] = {&a};
        hipError_t e = hipLaunchCooperativeKernel((const void*)mega_fwd, dim3(grid), dim3(512), kargs, LDS_BYTES, stream);
        if (e != hipSuccess) { fprintf(stderr, "launch %d failed: %s\n", ph, hipGetErrorString(e)); break; } }
#else
    a.ph_lo = 0; a.ph_hi = NPHASE; void* kargs[] = {&a};
    hipError_t e = hipLaunchCooperativeKernel((const void*)mega_fwd, dim3(grid), dim3(512), kargs, LDS_BYTES, stream);
    if (e != hipSuccess) fprintf(stderr, "cooperative launch failed: %s (grid %d)\n", hipGetErrorString(e), grid);
#endif
}
```
